# Optimizing an MI355X kernel written in HIP

```python
import math
import jax, jax.numpy as jnp
from jax import lax
import numpy as np

D_MODEL = 1024
BATCH = 8
SEQ = 2048
DEPTH = 4
DEC_BATCH = 128
DEC_SEQ = 8
PAST_LEN = 16384
PAGE_SIZE = 128

N_META = 16
EPS = 1e-6
GLA_HEADS = 4
GLA_DK = 64
GLA_DV = 128
GLA_KW = GLA_HEADS * GLA_DK
GLA_VW = GLA_HEADS * GLA_DV
GLA_RANK = 16
GLA_TAU = 16.0
GLA_CHUNK = 16
SSD_HEADS = 8
SSD_HEADDIM = 64
SSD_INNER = SSD_HEADS * SSD_HEADDIM
SSD_GROUPS = 2
SSD_REP = SSD_HEADS // SSD_GROUPS
SSD_DSTATE = 128
SSD_CONV = 4
SSD_CHUNK = 64
CONV_DIM = SSD_INNER + 2 * SSD_GROUPS * SSD_DSTATE
MIX_WIDTH = GLA_VW + SSD_INNER
PEER_HEADS = 8
PEER_NKEYS = 128
PEER_EXPERTS = PEER_NKEYS * PEER_NKEYS
PEER_QDIM = 128
PEER_TOPK = 16
PEER_BLOCK = 256
IN_SPLITS = (GLA_KW, GLA_KW, GLA_VW, GLA_VW, GLA_RANK, SSD_INNER, CONV_DIM, SSD_HEADS)
IN_WIDTH = GLA_KW + GLA_KW + GLA_VW + GLA_VW + GLA_RANK + SSD_INNER + CONV_DIM + SSD_HEADS

kernel_name = 'hymba_gla_ssd_peer_decoder_step'


def rmsnorm(x, w):
    xf = x.astype(jnp.float32)
    y = xf * lax.rsqrt(jnp.mean(xf * xf, axis=-1, keepdims=True) + EPS)
    return (y * w.astype(jnp.float32)).astype(x.dtype)


def segments(seq_len, split):
    return [(0, split), (split, seq_len)] if split > 0 else [(0, seq_len)]


def gla_segment(q, k, v, gk, s0):
    bsz, seg_len = q.shape[0], q.shape[1]
    c = math.gcd(seg_len, GLA_CHUNK)
    n = seg_len // c
    q, k, v, gk = (t.reshape((bsz, n, c) + t.shape[2:]) for t in (q, k, v, gk))
    b = jnp.cumsum(gk, axis=2)
    causal = jnp.tril(jnp.ones((c, c), dtype=bool))[None, None, :, :, None, None]
    decay = jnp.exp(jnp.where(causal, b[:, :, :, None] - b[:, :, None], -jnp.inf))
    attn = jnp.sum(q[:, :, :, None] * decay * k[:, :, None], axis=-1)
    o_intra = jnp.einsum('bntsh,bnshe->bnthe', attn, v)
    b_last = b[:, :, -1]
    s_local = jnp.einsum('bnshd,bnshe->bnhde', k * jnp.exp(b_last[:, :, None] - b), v)

    def step(s, inp):
        bl, sl = inp
        return jnp.exp(bl)[..., None] * s + sl, s

    s_fin, s_start = lax.scan(step, s0, (jnp.moveaxis(b_last, 1, 0), jnp.moveaxis(s_local, 1, 0)))
    s_start = jnp.moveaxis(s_start, 0, 1)
    o_inter = jnp.einsum('bnthd,bnhde->bnthe', q * jnp.exp(b), s_start)
    o = (o_intra + o_inter).reshape((bsz, seg_len) + o_intra.shape[3:])
    return o, s_fin


def ssd_segment(x, dt, a, bm, cm, h0):
    bsz, seg_len = x.shape[0], x.shape[1]
    c = math.gcd(seg_len, SSD_CHUNK)
    n = seg_len // c
    x, dt, bm, cm = (t.reshape((bsz, n, c) + t.shape[2:]) for t in (x, dt, bm, cm))
    cum = jnp.cumsum(dt * a, axis=2)
    causal = jnp.tril(jnp.ones((c, c), dtype=bool))[None, None, :, :, None, None]
    lmat = jnp.exp(jnp.where(causal, cum[:, :, :, None] - cum[:, :, None], -jnp.inf))
    cb = jnp.einsum('bntgk,bnsgk->bntsg', cm, bm)
    m = cb[..., None] * lmat * dt[:, :, None]
    y_intra = jnp.einsum('bntsgr,bnsgrp->bntgrp', m, x)
    cum_last = cum[:, :, -1]
    xw = x * (jnp.exp(cum_last[:, :, None] - cum) * dt)[..., None]
    s_local = jnp.einsum('bnsgk,bnsgrp->bngrpk', bm, xw)

    def step(h, inp):
        cl, sl = inp
        return jnp.exp(cl)[..., None, None] * h + sl, h

    h_fin, h_start = lax.scan(step, h0, (jnp.moveaxis(cum_last, 1, 0), jnp.moveaxis(s_local, 1, 0)))
    h_start = jnp.moveaxis(h_start, 0, 1)
    y_inter = jnp.einsum('bntgk,bngrpk->bntgrp', cm, h_start) * jnp.exp(cum)[..., None]
    y = (y_intra + y_inter).reshape((bsz, seg_len) + y_intra.shape[3:])
    return y, h_fin


def causal_conv(xbc, buf, w, b):
    seq_len = xbc.shape[1]
    full = jnp.concatenate([buf.astype(xbc.dtype), xbc], axis=1)
    out = b + full[:, 0:seq_len] * w[0]
    for i in range(1, SSD_CONV):
        out = out + full[:, i:i + seq_len] * w[i]
    return out, full[:, -(SSD_CONV - 1):]


def token_mixers(xn, s_gla, s_ssm, s_conv, split, w_in, w_gk2, b_gk2, gla_norm_w,
                 conv_w, conv_b, dt_bias, a_log, d_skip, ssd_norm_w, w_out):
    f32 = jnp.float32
    bsz, seq_len, _ = xn.shape
    dtype = xn.dtype
    offs = np.cumsum(IN_SPLITS)[:-1].tolist()
    q, k, v, g, f_lr, z, xbc, dt_raw = jnp.split(xn @ w_in, offs, axis=-1)
    segs = segments(seq_len, split)
    q = (q.astype(f32) * GLA_DK ** -0.5).reshape(bsz, seq_len, GLA_HEADS, GLA_DK)
    k = k.astype(f32).reshape(bsz, seq_len, GLA_HEADS, GLA_DK)
    v = v.astype(f32).reshape(bsz, seq_len, GLA_HEADS, GLA_DV)
    gk = (jax.nn.log_sigmoid((f_lr @ w_gk2 + b_gk2).astype(f32)) / GLA_TAU).reshape(bsz, seq_len, GLA_HEADS, GLA_DK)
    s = s_gla.astype(f32)
    outs = []
    for lo, hi in segs:
        o, s = gla_segment(q[:, lo:hi], k[:, lo:hi], v[:, lo:hi], gk[:, lo:hi], s)
        outs.append(o)
    o = jnp.concatenate(outs, axis=1)
    o_gla = (rmsnorm(o, gla_norm_w) * jax.nn.silu(g.astype(f32)).reshape(bsz, seq_len, GLA_HEADS, GLA_DV)).reshape(bsz, seq_len, GLA_VW)
    xbc_c, new_conv = causal_conv(xbc, s_conv, conv_w, conv_b)
    xbc_c = jax.nn.silu(xbc_c.astype(f32))
    xs, bm, cm = jnp.split(xbc_c, [SSD_INNER, SSD_INNER + SSD_GROUPS * SSD_DSTATE], axis=-1)
    xs = xs.reshape(bsz, seq_len, SSD_GROUPS, SSD_REP, SSD_HEADDIM)
    bm = bm.reshape(bsz, seq_len, SSD_GROUPS, SSD_DSTATE)
    cm = cm.reshape(bsz, seq_len, SSD_GROUPS, SSD_DSTATE)
    dt = jax.nn.softplus(dt_raw.astype(f32) + dt_bias.astype(f32)).reshape(bsz, seq_len, SSD_GROUPS, SSD_REP)
    a = -jnp.exp(a_log.astype(f32)).reshape(SSD_GROUPS, SSD_REP)
    h = s_ssm.astype(f32).reshape(bsz, SSD_GROUPS, SSD_REP, SSD_HEADDIM, SSD_DSTATE)
    ys = []
    for lo, hi in segs:
        y, h = ssd_segment(xs[:, lo:hi], dt[:, lo:hi], a, bm[:, lo:hi], cm[:, lo:hi], h)
        ys.append(y)
    y = jnp.concatenate(ys, axis=1) + d_skip.astype(f32).reshape(SSD_GROUPS, SSD_REP)[..., None] * xs
    y = rmsnorm(y.reshape(bsz, seq_len, SSD_INNER) * jax.nn.silu(z.astype(f32)), ssd_norm_w)
    mix = jnp.concatenate([o_gla, y], axis=-1).astype(dtype)
    out = mix @ w_out
    new_ssm = h.reshape(bsz, SSD_HEADS, SSD_HEADDIM, SSD_DSTATE)
    return out, s.astype(s_gla.dtype), new_ssm.astype(s_ssm.dtype), new_conv.astype(s_conv.dtype)


def peer(xn, w_q, sub_k1, sub_k2, u, v):
    shape = xn.shape
    t = xn.reshape(-1, D_MODEL)
    n_tok = t.shape[0]
    q = (t @ w_q).astype(jnp.float32).reshape(n_tok, PEER_HEADS, 2, PEER_QDIM // 2)
    s1 = jnp.einsum('thd,kd->thk', q[:, :, 0], sub_k1.astype(jnp.float32))
    s2 = jnp.einsum('thd,kd->thk', q[:, :, 1], sub_k2.astype(jnp.float32))
    v1, i1 = lax.top_k(s1, PEER_TOPK)
    v2, i2 = lax.top_k(s2, PEER_TOPK)
    cand = (v1[..., :, None] + v2[..., None, :]).reshape(n_tok, PEER_HEADS, PEER_TOPK * PEER_TOPK)
    sc, ci = lax.top_k(cand, PEER_TOPK)
    e = (jnp.take_along_axis(i1, ci // PEER_TOPK, axis=-1) * PEER_NKEYS
         + jnp.take_along_axis(i2, ci % PEER_TOPK, axis=-1))
    gate = jax.nn.softmax(sc, axis=-1)
    e = e.reshape(n_tok, PEER_HEADS * PEER_TOPK)
    gate = gate.reshape(n_tok, PEER_HEADS * PEER_TOPK).astype(xn.dtype)
    pad = (-n_tok) % PEER_BLOCK
    tp = jnp.pad(t, ((0, pad), (0, 0))).reshape(-1, PEER_BLOCK, D_MODEL)
    ep = jnp.pad(e, ((0, pad), (0, 0))).reshape(-1, PEER_BLOCK, PEER_HEADS * PEER_TOPK)
    gp = jnp.pad(gate, ((0, pad), (0, 0))).reshape(-1, PEER_BLOCK, PEER_HEADS * PEER_TOPK)

    def blk(args):
        tb, eb, gb = args
        hid = jnp.einsum('tkd,td->tk', u[eb], tb)
        return jnp.einsum('tk,tkd->td', gb * jax.nn.gelu(hid), v[eb])

    out = lax.map(blk, (tp, ep, gp))
    return out.reshape(-1, D_MODEL)[:n_tok].reshape(shape)


def setup_inputs(seed: int = 0) -> dict:
    key = jax.random.key(seed)
    ks = jax.random.split(key, 32)
    f32 = jnp.float32

    def nrm(i, shape, s):
        return jax.random.normal(ks[i], shape, f32) * s

    dt0 = jnp.exp(jax.random.uniform(ks[10], (DEPTH, SSD_HEADS), f32, math.log(1e-3), math.log(1e-1)))
    return {
        'x_prompt': nrm(0, (BATCH, SEQ, D_MODEL), 1.0),
        'x_sample': nrm(1, (DEC_BATCH, DEC_SEQ, D_MODEL), 1.0),
        'state_gla': nrm(2, (DEPTH, DEC_BATCH, GLA_HEADS, GLA_DK, GLA_DV), 0.5),
        'state_ssm': nrm(3, (DEPTH, DEC_BATCH, SSD_HEADS, SSD_HEADDIM, SSD_DSTATE), 0.5),
        'state_conv': nrm(4, (DEPTH, DEC_BATCH, SSD_CONV - 1, CONV_DIM), 1.0),
        'meta_tokens': nrm(5, (N_META, D_MODEL), 1.0),
        'norm1_w': 1.0 + nrm(6, (DEPTH, D_MODEL), 0.02),
        'w_in': nrm(7, (DEPTH, D_MODEL, IN_WIDTH), D_MODEL ** -0.5),
        'w_gk2': nrm(8, (DEPTH, GLA_RANK, GLA_KW), GLA_RANK ** -0.5),
        'b_gk2': nrm(9, (DEPTH, GLA_KW), 0.01) + 1.0,
        'gla_norm_w': 1.0 + nrm(11, (DEPTH, GLA_DV), 0.02),
        'conv_w': nrm(12, (DEPTH, SSD_CONV, CONV_DIM), 0.5),
        'conv_b': nrm(13, (DEPTH, CONV_DIM), 0.01),
        'dt_bias': dt0 + jnp.log(-jnp.expm1(-dt0)),
        'a_log': jnp.log(jax.random.uniform(ks[14], (DEPTH, SSD_HEADS), f32, 1.0, 16.0)),
        'd_skip': 1.0 + nrm(15, (DEPTH, SSD_HEADS), 0.01),
        'ssd_norm_w': 1.0 + nrm(16, (DEPTH, SSD_INNER), 0.02),
        'w_out': nrm(17, (DEPTH, MIX_WIDTH, D_MODEL), MIX_WIDTH ** -0.5),
        'norm2_w': 1.0 + nrm(18, (DEPTH, D_MODEL), 0.02),
        'peer_wq': nrm(19, (DEPTH, D_MODEL, PEER_HEADS * PEER_QDIM), D_MODEL ** -0.5),
        'peer_k1': nrm(20, (DEPTH, PEER_NKEYS, PEER_QDIM // 2), (PEER_QDIM // 2) ** -0.5),
        'peer_k2': nrm(21, (DEPTH, PEER_NKEYS, PEER_QDIM // 2), (PEER_QDIM // 2) ** -0.5),
        'peer_u': nrm(22, (DEPTH, PEER_EXPERTS, D_MODEL), D_MODEL ** -0.5),
        'peer_v': nrm(23, (DEPTH, PEER_EXPERTS, D_MODEL), (PEER_HEADS * PEER_TOPK) ** -0.5),
        'final_norm_w': 1.0 + nrm(24, (D_MODEL,), 0.02),
    }


def reference(x_prompt, x_sample, state_gla, state_ssm, state_conv, meta_tokens, norm1_w, w_in,
              w_gk2, b_gk2, gla_norm_w, conv_w, conv_b, dt_bias, a_log, d_skip, ssd_norm_w, w_out,
              norm2_w, peer_wq, peer_k1, peer_k2, peer_u, peer_v, final_norm_w):
    dtype = x_prompt.dtype
    bp = x_prompt.shape[0]
    hp = jnp.concatenate([jnp.broadcast_to(meta_tokens[None].astype(dtype), (bp, N_META, D_MODEL)), x_prompt], axis=1)
    hs = x_sample
    gp = jnp.zeros((bp, GLA_HEADS, GLA_DK, GLA_DV), dtype)
    sp = jnp.zeros((bp, SSD_HEADS, SSD_HEADDIM, SSD_DSTATE), dtype)
    cp = jnp.zeros((bp, SSD_CONV - 1, CONV_DIM), dtype)

    def layer(h, sg, ss, sc, split, l):
        m, sg, ss, sc = token_mixers(rmsnorm(h, norm1_w[l]), sg, ss, sc, split, w_in[l], w_gk2[l], b_gk2[l],
                                     gla_norm_w[l], conv_w[l], conv_b[l], dt_bias[l], a_log[l], d_skip[l],
                                     ssd_norm_w[l], w_out[l])
        h = h + m
        h = h + peer(rmsnorm(h, norm2_w[l]), peer_wq[l], peer_k1[l], peer_k2[l], peer_u[l], peer_v[l])
        return h, sg, ss, sc

    gla_p, ssm_p, conv_p, gla_s, ssm_s, conv_s = [], [], [], [], [], []
    for l in range(DEPTH):
        hp, g1, s1, c1 = layer(hp, gp, sp, cp, N_META, l)
        hs, g2, s2, c2 = layer(hs, state_gla[l], state_ssm[l], state_conv[l], 0, l)
        gla_p.append(g1); ssm_p.append(s1); conv_p.append(c1)
        gla_s.append(g2); ssm_s.append(s2); conv_s.append(c2)
    y_prompt = rmsnorm(hp, final_norm_w)[:, N_META:]
    y_sample = rmsnorm(hs, final_norm_w)
    return (y_prompt, y_sample, jnp.stack(gla_p), jnp.stack(ssm_p), jnp.stack(conv_p),
            jnp.stack(gla_s), jnp.stack(ssm_s), jnp.stack(conv_s))
```

```cpp
#include <hip/hip_runtime.h>
#include <cstdio>
#include <cstdint>

#ifndef MK_ONE_LAUNCH
#define MK_ONE_LAUNCH 1
#endif

__device__ __forceinline__ int opaque_tid() { int t = threadIdx.x; asm volatile("" : "+v"(t)); return t; }
__device__ __forceinline__ int opaque_bid() { int b = blockIdx.x; asm volatile("" : "+s"(b)); return b; }
namespace pg8 {
#define PG8_LAS __attribute__((address_space(3)))
typedef unsigned short bf16_t;
typedef short bf16x8 __attribute__((ext_vector_type(8)));
typedef float f32x4 __attribute__((ext_vector_type(4)));
typedef unsigned u32x4 __attribute__((ext_vector_type(4)));
typedef unsigned u32x2 __attribute__((ext_vector_type(2)));
constexpr int BM = 256, BK = 64, HALF = 128, HTB = HALF * BK * 2, STAGE_BYTES = 8 * HTB, NXCD = 8, WGM = 8;

__host__ __device__ __forceinline__ int lds_byte(int r, int c) { const int st = (r >> 4) * 2 + (c >> 5), rr = r & 15, cc = c & 31, ob = rr * 64 + cc * 2; return st * 1024 + (ob ^ (((ob >> 9) & 1) << 5)); }
__host__ __device__ __forceinline__ void stage_rc(int b, int& R, int& C) { const int st = b / 1024, sb = b % 1024, swz = sb ^ (((sb >> 9) & 1) << 5); R = (st >> 1) * 16 + swz / 64; C = (st & 1) * 32 + (swz % 64) / 2; }
__host__ __device__ __forceinline__ int perm32(int rho) { const int n = rho >> 4, i = rho & 15; return 8 * (i >> 2) + 4 * n + (i & 3); }

struct Unit { int pm, pn; };
struct Gemm { const bf16_t* A; const bf16_t* Bt; int M, N, K; };

struct StaticOrder {
    int nM, nN, nwg, G, c;
    __host__ __device__ void init(int M, int N, int G_, int c_) { nM = M / BM; nN = N / BM; nwg = nM * nN; G = G_; c = c_; }
    __host__ __device__ bool next(int i, Unit& u) const {
        const long L = (long)i * G + c; if (L >= nwg) return false;
        int wgid = (int)L; { const int q = nwg / NXCD, r = nwg % NXCD, xcd = wgid % NXCD, off = wgid / NXCD; wgid = (xcd < r ? xcd * (q + 1) : r * (q + 1) + (xcd - r) * q) + off; }
        const int nig = WGM * nN, gid = wgid / nig, fm = gid * WGM, gsz = (nM - fm) < WGM ? (nM - fm) : WGM;
        u.pm = fm + ((wgid % nig) % gsz); u.pn = (wgid % nig) / gsz; return true;
    }
    __device__ __forceinline__ void a_ready(const Unit&) const {}
    __device__ __forceinline__ void done(const Unit&) const {}
};

__device__ __forceinline__ unsigned cvt_pk_bf16(float lo, float hi) { unsigned r; asm volatile("v_cvt_pk_bf16_f32 %0, %1, %2" : "=v"(r) : "v"(lo), "v"(hi)); return r; }


struct EpiUni {
    static constexpr bool PERM = true, AFTER_DRAIN = false;
    int mode; bf16_t* O; int ldc; const float* ssq; int nparts; float* H; float* ssqp;
    __device__ __forceinline__ void operator()(const f32x4 (&acc)[2][2][4][2], const Unit& u, int wr, int wc, int fr, int fq) const {
        const int row0 = u.pm * BM + wr * 64 + fr; const int col0 = u.pn * BM + wc * 32 + 8 * fq;
        if (mode == 0) {
#pragma unroll
            for (int ai = 0; ai < 2; ++ai)
#pragma unroll
                for (int m = 0; m < 4; ++m) {
                    const int row = row0 + ai * HALF + m * 16;
                    float s = 0.f;
                    for (int i = 0; i < nparts; ++i) s += ssq[(size_t)row * nparts + i];
                    const float sc = rsqrtf(s * (1.0f / 1024.0f) + 1e-6f);
                    bf16_t* rowp = O + (size_t)row * ldc + col0;
#pragma unroll
                    for (int bj = 0; bj < 2; ++bj) { f32x4 v0 = acc[ai][bj][m][0] * sc, v1 = acc[ai][bj][m][1] * sc;
                        u32x4 w; w.x = cvt_pk_bf16(v0[0], v0[1]); w.y = cvt_pk_bf16(v0[2], v0[3]); w.z = cvt_pk_bf16(v1[0], v1[1]); w.w = cvt_pk_bf16(v1[2], v1[3]);
                        *(u32x4*)(rowp + bj * HALF) = w; } }
        } else {
#pragma unroll
            for (int ai = 0; ai < 2; ++ai)
#pragma unroll
                for (int m = 0; m < 4; ++m) {
                    const int row = row0 + ai * HALF + m * 16; float ss = 0.f;
#pragma unroll
                    for (int bj = 0; bj < 2; ++bj) {
                        const size_t off = (size_t)row * 1024 + col0 + bj * HALF;
                        f32x4 h0 = *(const f32x4*)(H + off), h1 = *(const f32x4*)(H + off + 4);
                        h0 = h0 + acc[ai][bj][m][0]; h1 = h1 + acc[ai][bj][m][1];
                        *(f32x4*)(H + off) = h0; *(f32x4*)(H + off + 4) = h1;
                        u32x4 w; w.x = cvt_pk_bf16(h0[0], h0[1]); w.y = cvt_pk_bf16(h0[2], h0[3]); w.z = cvt_pk_bf16(h1[0], h1[1]); w.w = cvt_pk_bf16(h1[2], h1[3]);
                        *(u32x4*)(O + off) = w;
                        ss += (h0[0] * h0[0] + h0[1] * h0[1]) + (h0[2] * h0[2] + h0[3] * h0[3]) + (h1[0] * h1[0] + h1[1] * h1[1]) + (h1[2] * h1[2] + h1[3] * h1[3]);
                    }
                    ss += __shfl_xor(ss, 16); ss += __shfl_xor(ss, 32);
                    if (fq == 0) ssqp[(size_t)row * 16 + u.pn * 4 + wc] = ss;
                }
        }
    }
};

template <class Epi, class Sched, bool ALIGN_EPI = false, bool SP2 = false>
__device__ __forceinline__ void gemm_phase(PG8_LAS unsigned char* lds, const Gemm g, const Sched& S, const Epi& E) {
    const int tid = opaque_tid(), wid = __builtin_amdgcn_readfirstlane(tid >> 6), lane = tid & 63, wr = wid >> 2, wc = wid & 3, fr = lane & 15, fq = lane >> 4;
    const int K = g.K, nt = K / BK;
    unsigned voffA[2], voffB[2];
#pragma unroll
    for (int i = 0; i < 2; ++i) { int R, C; stage_rc(tid * 16 + i * 8192, R, C); const int Rb = Epi::PERM ? ((R & ~31) + perm32(R & 31)) : R;
        voffA[i] = (unsigned)(R * K + C) * 2u; voffB[i] = (unsigned)(Rb * K + C) * 2u; }
    const size_t kstep = (size_t)(BK * 2);
    const size_t hstep = (size_t)HALF * K * 2;
    const size_t tstep = 2 * hstep;
    const unsigned ldsw = (unsigned)wid * 1024u;
    const int aoff = lds_byte(wr * 64 + fr, fq * 8), boff = lds_byte(wc * 32 + fr, fq * 8);
#define PG8_SA(b, h) (((b) * 2 + (h)) * HTB)
#define PG8_SB(b, h) ((4 + (b) * 2 + (h)) * HTB)
#define PG8_STAGE(bufoff, gbase, voff) do { _Pragma("unroll") for (int _i = 0; _i < 2; ++_i) \
        __builtin_amdgcn_global_load_lds((const unsigned*)((const char*)(gbase) + (voff)[_i]), (PG8_LAS unsigned*)(lds + (bufoff) + ldsw + _i * 8192), 16, 0, 0); } while (0)
#define PG8_LDA(dst, b, h) do { _Pragma("unroll") for (int m = 0; m < 4; ++m) _Pragma("unroll") for (int k = 0; k < 2; ++k) dst[m][k] = *(const PG8_LAS bf16x8*)(lds + PG8_SA(b, h) + aoff + m * 2048 + k * 1024); } while (0)
#define PG8_LDB(dst, b, h) do { _Pragma("unroll") for (int n = 0; n < 2; ++n) _Pragma("unroll") for (int k = 0; k < 2; ++k) dst[n][k] = *(const PG8_LAS bf16x8*)(lds + PG8_SB(b, h) + boff + n * 2048 + k * 1024); } while (0)
#define PG8_MMA(ai, bj, At, Bt) do { __builtin_amdgcn_s_setprio(1); _Pragma("unroll") for (int m = 0; m < 4; ++m) _Pragma("unroll") for (int n = 0; n < 2; ++n) _Pragma("unroll") for (int k = 0; k < 2; ++k) \
        acc[ai][bj][m][n] = __builtin_amdgcn_mfma_f32_16x16x32_bf16(Bt[n][k], At[m][k], acc[ai][bj][m][n], 0, 0, 0); __builtin_amdgcn_s_setprio(0); } while (0)
#define PG8_WAIT_V(n) asm volatile("s_waitcnt vmcnt(" #n ")" ::: "memory")
#define PG8_WAIT_L(n) asm volatile("s_waitcnt lgkmcnt(" #n ")" ::: "memory")
#define PG8_BAR __builtin_amdgcn_s_barrier()
#define PG8_SCHED __builtin_amdgcn_sched_barrier(0)
    Unit cur, nxt; int ui = 0;
    if (!S.next(0, cur)) return;
    f32x4 acc[2][2][4][2];
#pragma unroll
    for (int a = 0; a < 2; ++a)
#pragma unroll
        for (int b = 0; b < 2; ++b)
#pragma unroll
            for (int m = 0; m < 4; ++m)
#pragma unroll
                for (int n = 0; n < 2; ++n) acc[a][b][m][n] = (f32x4){0.f, 0.f, 0.f, 0.f};
    bf16x8 At[4][2], B0[2][2], B1[2][2];
    const char* cA = (const char*)g.A + (size_t)cur.pm * tstep; const char* cB = (const char*)g.Bt + (size_t)cur.pn * tstep;
    S.a_ready(cur);
    if constexpr (SP2) {
        PG8_STAGE(PG8_SB(0, 0), cB, voffB); PG8_STAGE(PG8_SB(0, 1), cB + hstep, voffB); PG8_STAGE(PG8_SA(0, 0), cA, voffA); PG8_STAGE(PG8_SA(0, 1), cA + hstep, voffA);
        if (wr == 1) PG8_BAR;
        PG8_WAIT_V(2); PG8_BAR;
        PG8_STAGE(PG8_SB(1, 0), cB + kstep, voffB); PG8_STAGE(PG8_SA(1, 0), cA + kstep, voffA); PG8_STAGE(PG8_SB(1, 1), cB + hstep + kstep, voffB);
        PG8_WAIT_V(6); PG8_BAR;
    } else {
        PG8_STAGE(PG8_SB(0, 0), cB, voffB); PG8_STAGE(PG8_SA(0, 0), cA, voffA); PG8_STAGE(PG8_SB(0, 1), cB + hstep, voffB); PG8_STAGE(PG8_SA(0, 1), cA + hstep, voffA);
        if (wr == 1) PG8_BAR;
        PG8_WAIT_V(4); PG8_BAR;
        PG8_STAGE(PG8_SB(1, 0), cB + kstep, voffB); PG8_STAGE(PG8_SA(1, 0), cA + kstep, voffA); PG8_STAGE(PG8_SB(1, 1), cB + hstep + kstep, voffB);
        PG8_WAIT_V(6); PG8_BAR;
    }
    for (;;) {
        const bool has_next = S.next(ui + 1, nxt);
        const char* nA = has_next ? (const char*)g.A + (size_t)nxt.pm * tstep : cA; const char* nB = has_next ? (const char*)g.Bt + (size_t)nxt.pn * tstep : cB;
        for (int t = 0; t < nt; t += 2) {
            const bool last = (t == nt - 2);
            const char* a1 = cA + (size_t)(t + 1) * kstep;
            const char* a2 = last ? nA : cA + (size_t)(t + 2) * kstep; const char* b2 = last ? nB : cB + (size_t)(t + 2) * kstep;
            const char* a3 = a2 + kstep; const char* b3 = b2 + kstep;
            if (last && has_next) S.a_ready(nxt);
            if constexpr (SP2) {
            PG8_LDB(B0, 0, 0); PG8_LDB(B1, 0, 1); PG8_SCHED; PG8_LDA(At, 0, 0); PG8_STAGE(PG8_SA(1, 1), a1 + hstep, voffA);
            PG8_WAIT_V(8); PG8_WAIT_L(0); PG8_BAR; PG8_MMA(0, 0, At, B0); PG8_MMA(0, 1, At, B1); PG8_BAR; PG8_SCHED;
            PG8_LDA(At, 0, 1); PG8_STAGE(PG8_SB(0, 0), b2, voffB); PG8_STAGE(PG8_SB(0, 1), b2 + hstep, voffB); PG8_STAGE(PG8_SA(0, 0), a2, voffA);
            PG8_WAIT_V(8); PG8_WAIT_L(0); PG8_BAR; PG8_MMA(1, 0, At, B0); PG8_MMA(1, 1, At, B1); PG8_BAR; PG8_SCHED;
            PG8_LDB(B0, 1, 0); PG8_LDB(B1, 1, 1); PG8_SCHED; PG8_LDA(At, 1, 0); PG8_STAGE(PG8_SA(0, 1), a2 + hstep, voffA);
            PG8_WAIT_V(8); PG8_WAIT_L(0); PG8_BAR; PG8_MMA(0, 0, At, B0); PG8_MMA(0, 1, At, B1); PG8_BAR; PG8_SCHED;
            PG8_LDA(At, 1, 1); PG8_STAGE(PG8_SB(1, 0), b3, voffB); PG8_STAGE(PG8_SB(1, 1), b3 + hstep, voffB); PG8_STAGE(PG8_SA(1, 0), a3, voffA);
            PG8_WAIT_V(8); PG8_WAIT_L(0); PG8_BAR; PG8_MMA(1, 0, At, B0); PG8_MMA(1, 1, At, B1); PG8_BAR; PG8_SCHED;
            } else {
            PG8_LDB(B0, 0, 0); PG8_SCHED; PG8_LDA(At, 0, 0); PG8_STAGE(PG8_SA(1, 1), a1 + hstep, voffA);
            PG8_WAIT_L(8); PG8_BAR; PG8_WAIT_L(0); PG8_MMA(0, 0, At, B0); PG8_BAR; PG8_SCHED;
            PG8_LDB(B1, 0, 1); PG8_STAGE(PG8_SB(0, 0), b2, voffB);
            PG8_BAR; PG8_WAIT_L(0); PG8_MMA(0, 1, At, B1); PG8_BAR;
            PG8_LDA(At, 0, 1); PG8_STAGE(PG8_SA(0, 0), a2, voffA);
            PG8_BAR; PG8_WAIT_L(0); PG8_MMA(1, 0, At, B0); PG8_BAR; PG8_SCHED;
            PG8_STAGE(PG8_SB(0, 1), b2 + hstep, voffB);
            PG8_WAIT_V(6); PG8_BAR; PG8_MMA(1, 1, At, B1); PG8_BAR;
            PG8_LDB(B0, 1, 0); PG8_SCHED; PG8_LDA(At, 1, 0); PG8_STAGE(PG8_SA(0, 1), a2 + hstep, voffA);
            PG8_WAIT_L(8); PG8_BAR; PG8_WAIT_L(0); PG8_MMA(0, 0, At, B0); PG8_BAR; PG8_SCHED;
            PG8_LDB(B1, 1, 1); PG8_STAGE(PG8_SB(1, 0), b3, voffB);
            PG8_BAR; PG8_WAIT_L(0); PG8_MMA(0, 1, At, B1); PG8_BAR;
            PG8_LDA(At, 1, 1); PG8_STAGE(PG8_SA(1, 0), a3, voffA);
            PG8_BAR; PG8_WAIT_L(0); PG8_MMA(1, 0, At, B0); PG8_BAR; PG8_SCHED;
            PG8_STAGE(PG8_SB(1, 1), b3 + hstep, voffB);
            PG8_WAIT_V(6); PG8_BAR; PG8_MMA(1, 1, At, B1); PG8_BAR;
            }
        }
        if constexpr (ALIGN_EPI) { if (wr == 0) PG8_BAR; }
        if constexpr (!Epi::AFTER_DRAIN) { E(acc, cur, wr, wc, fr, fq); S.done(cur); }
        if (!has_next) break;
#pragma unroll
        for (int a = 0; a < 2; ++a)
#pragma unroll
            for (int b = 0; b < 2; ++b)
#pragma unroll
                for (int m = 0; m < 4; ++m)
#pragma unroll
                    for (int n = 0; n < 2; ++n) acc[a][b][m][n] = (f32x4){0.f, 0.f, 0.f, 0.f};
        cur = nxt; cA = nA; cB = nB; ++ui;
        if constexpr (ALIGN_EPI) { if (wr == 1) PG8_BAR; }
    }
    PG8_WAIT_V(0);
    if constexpr (!ALIGN_EPI) { if (wr == 0) PG8_BAR; }
    PG8_BAR;
#undef PG8_SA
#undef PG8_SB
#undef PG8_STAGE
#undef PG8_LDA
#undef PG8_LDB
#undef PG8_MMA
#undef PG8_WAIT_V
#undef PG8_WAIT_L
#undef PG8_BAR
#undef PG8_SCHED
}
}

constexpr int NWAVES = 8, NTHR = 512;
constexpr int DM = 1024, NLAY = 4;
constexpr int PB = 8, PL = 2064, PT = PB * PL, SB = 128, SL = 8, ST = SB * SL, T = PT + ST, MP = 17664;
constexpr int NCH = 33;
constexpr int NIN = 3328;
constexpr int CQ = 0, CK = 256, CV = 512, CG = 1024, CZ = 1536, CX = 2048, CF = 3072, CDT = 3088;
constexpr int NGLA_P = PB * NCH * 4, NGLA_S = SB * 4, NGLA = NGLA_P + NGLA_S;
constexpr int NSSD_P = PB * NCH * 8, NSSD_S = SB * 8, NSSD = NSSD_P + NSSD_S;
constexpr float EPS = 1e-6f;
constexpr size_t O_YP = 0, O_YS = 16777216, O_GP = 17825792, O_SP = 18874368, O_CP = 20971520, O_GS = 21069824, O_SS = 37847040, O_CS = 71401472;

constexpr size_t al256(size_t x) { return (x + 255) & ~(size_t)255; }
constexpr size_t WS_CTL = 0, CTL_BYTES = 1u << 20;
constexpr size_t WS_WIN = WS_CTL + CTL_BYTES;
constexpr size_t WS_WOUT = WS_WIN + (size_t)NLAY * NIN * DM * 2;
constexpr size_t WS_WQ = WS_WOUT + (size_t)NLAY * DM * DM * 2;
constexpr size_t WS_UB = WS_WQ + (size_t)NLAY * DM * DM * 2;
constexpr size_t WS_VB = WS_UB + (size_t)NLAY * 16384 * DM;
constexpr size_t WS_US = WS_VB + (size_t)NLAY * 16384 * DM;
constexpr size_t WS_VS = WS_US + (size_t)NLAY * 16384 * 4;
constexpr size_t WS_H = WS_VS + (size_t)NLAY * 16384 * 4;
constexpr size_t WS_HB = WS_H + (size_t)MP * DM * 4;
constexpr size_t WS_PROJ = WS_HB + (size_t)MP * DM * 2;
constexpr size_t WS_MIX = WS_PROJ + (size_t)MP * NIN * 2;
constexpr size_t WS_Q = WS_MIX + (size_t)MP * DM * 2;
constexpr size_t WS_SSQ1 = WS_Q + (size_t)MP * DM * 2;
constexpr size_t WS_SSQ2 = al256(WS_SSQ1 + (size_t)MP * 4);
constexpr size_t WS_RE = al256(WS_SSQ2 + (size_t)MP * 16 * 4);
constexpr size_t WS_RG = al256(WS_RE + (size_t)T * 128 * 4);
constexpr size_t WS_SG = al256(WS_RG + (size_t)T * 128 * 4);
constexpr size_t WS_DG = al256(WS_SG + (size_t)NGLA * 8192 * 4);
constexpr size_t WS_SS = al256(WS_DG + (size_t)NGLA * 64 * 4);
constexpr size_t WS_DS = al256(WS_SS + (size_t)NSSD * 8192 * 4);
constexpr size_t WS_BC = al256(WS_DS + (size_t)NSSD * 4);
constexpr size_t WS_XC = al256(WS_BC + (size_t)NGLA * 4096 * 4);
constexpr size_t WS_X8 = al256(WS_XC + (size_t)MP * 1024 * 2);
constexpr size_t WS_HS = al256(WS_X8 + (size_t)64 * T * 16);
constexpr size_t WS_PL = al256(WS_HS + (size_t)T * 4);
constexpr size_t WS_WP = al256(WS_PL + (size_t)256 * 10240 * 4);
constexpr size_t WS_END = al256(WS_WP + (size_t)T * 128 * 4);
constexpr int CW_BAR = 4096, CW_Q = 8192, CW_GC = 16384;

constexpr int LDS_BYTES = 163840;
constexpr int MISC_OFF = 163840 - 256;

typedef unsigned short bf16;
typedef float f32x4 __attribute__((ext_vector_type(4)));
typedef unsigned u32x4 __attribute__((ext_vector_type(4)));
typedef unsigned u32x2 __attribute__((ext_vector_type(2)));
#define LAS __attribute__((address_space(3)))

__device__ __forceinline__ float bf2f(unsigned short u) { return __uint_as_float(((unsigned)u) << 16); }
__device__ __forceinline__ float bflo(unsigned u) { return __uint_as_float(u << 16); }
__device__ __forceinline__ float bfhi(unsigned u) { return __uint_as_float(u & 0xffff0000u); }
typedef __bf16 bf16n2 __attribute__((ext_vector_type(2)));
typedef float f32p2 __attribute__((ext_vector_type(2)));
__device__ __forceinline__ unsigned f2bf(float f) { const __bf16 b = (__bf16)f; return (unsigned)__builtin_bit_cast(unsigned short, b); }
__device__ __forceinline__ unsigned pk2(float lo, float hi) { const f32p2 v = (f32p2){lo, hi}; const bf16n2 b = __builtin_convertvector(v, bf16n2); return __builtin_bit_cast(unsigned, b); }
__device__ __forceinline__ float siluf(float x) { return x * __builtin_amdgcn_rcpf(1.0f + __expf(-x)); }

#define XB_TMO      128
#define XB_XCNT(j)  (256  + 64 * (j))
#define XB_XSUB(j)  (1280 + 64 * (j))
#define XB_XGEN(j)  (2304 + 64 * (j))
#define XB_TOP      3328
#define XB_TOPGEN   3392
#define XCD_BAR_WORDS 3456
#define XB_SPIN_CAP (1u << 22)
__device__ __forceinline__ unsigned xb_ld(unsigned* p)              { return __hip_atomic_load(p, __ATOMIC_RELAXED, __HIP_MEMORY_SCOPE_AGENT); }
__device__ __forceinline__ unsigned xb_add(unsigned* p, unsigned v) { return __hip_atomic_fetch_add(p, v, __ATOMIC_RELAXED, __HIP_MEMORY_SCOPE_AGENT); }
__device__ __forceinline__ unsigned xb_xcc_id() { return (unsigned)__builtin_amdgcn_s_getreg((3 << 11) | 20) & 0xFu; }
#define XB_SPIN(cond, bar) do { unsigned _sp = 0; while (cond) { __builtin_amdgcn_s_sleep(1); \
    if ((++_sp & 255u) == 0u) { if (xb_ld(&(bar)[XB_TMO])) break; if (_sp > XB_SPIN_CAP) { atomicAdd(&(bar)[XB_TMO], 1u); break; } } } } while (0)
struct XcdBarrier { unsigned* bar; unsigned x; volatile LAS unsigned* st; };
__device__ __forceinline__ XcdBarrier xcd_barrier_post(unsigned* bar, volatile LAS unsigned* st) {
    XcdBarrier b; b.bar = bar; b.x = xb_xcc_id(); b.st = st;
    if (threadIdx.x == 0) (void)xb_add(&bar[XB_XCNT(b.x)], 1u);
    return b;
}
__device__ __forceinline__ void xcd_barrier_complete(unsigned* bar, unsigned x, unsigned& nloc, unsigned& nx) {
    const unsigned G = gridDim.x * gridDim.y * gridDim.z;
    unsigned sum, cnt, mine, sp = 0u;
    for (;;) {
        sum = 0u; cnt = 0u; mine = 0u;
#pragma unroll
        for (unsigned j = 0; j < 16; ++j) { const unsigned c = xb_ld(&bar[XB_XCNT(j)]); sum += c; cnt += (c > 0u) ? 1u : 0u; mine = (j == x) ? c : mine; }
        if (sum == G) break;
        __builtin_amdgcn_s_sleep(1);
        if ((++sp & 255u) == 0u) { if (xb_ld(&bar[XB_TMO])) break; if (sp > XB_SPIN_CAP) { atomicAdd(&bar[XB_TMO], 1u); break; } }
    }
    nloc = mine > 0u ? mine : 1u; nx = cnt > 0u ? cnt : 1u;
}
__device__ __forceinline__ void xcd_barrier(const XcdBarrier& b) {
    asm volatile("s_waitcnt vmcnt(0)" ::: "memory");
    __syncthreads();
    if (threadIdx.x == 0) {
        unsigned* bar = b.bar;
        __builtin_amdgcn_s_waitcnt(0);
        unsigned nloc = b.st[0], nx = b.st[1];
        if (nloc == 0u) { xcd_barrier_complete(bar, b.x, nloc, nx); b.st[0] = nloc; b.st[1] = nx; }
        const unsigned old = xb_add(&bar[XB_XSUB(b.x)], 1u);
        const unsigned gen = old / nloc;
        if (old + 1u == (gen + 1u) * nloc) {
            __builtin_amdgcn_fence(__ATOMIC_RELEASE, "agent");
            asm volatile("s_waitcnt vmcnt(0)" ::: "memory");
            const unsigned og = xb_add(&bar[XB_TOP], 1u);
            const unsigned tg = og / nx;
            if (og + 1u == (tg + 1u) * nx) xb_add(&bar[XB_TOPGEN], 1u);
            else XB_SPIN(xb_ld(&bar[XB_TOPGEN]) == tg, bar);
            __builtin_amdgcn_fence(__ATOMIC_ACQUIRE, "agent");
            xb_add(&bar[XB_XGEN(b.x)], 1u);
            asm volatile("s_waitcnt vmcnt(0)" ::: "memory");
        } else {
            XB_SPIN(xb_ld(&bar[XB_XGEN(b.x)]) == gen, bar);
            __builtin_amdgcn_fence(__ATOMIC_ACQUIRE, "agent");
            asm volatile("s_waitcnt vmcnt(0)" ::: "memory");
        }
    }
    __syncthreads();
}

struct Args { const float* in[25]; float* out; unsigned char* ws; int ph_lo, ph_hi; int rep[10]; };
#ifndef PROBE_REP
#define PROBE_REP {1, 1, 1, 1, 1, 1, 1, 1, 1, 1}
#endif
enum { I_XP = 0, I_XS, I_SGLA, I_SSSM, I_SCONV, I_META, I_N1W, I_WIN, I_WGK2, I_BGK2, I_GLANW, I_CONVW, I_CONVB, I_DTB, I_ALOG, I_DSKIP, I_SSDNW, I_WOUT, I_N2W, I_WQ, I_K1, I_K2, I_U, I_V, I_FNW };

__device__ __forceinline__ float wave_sum(float v) {
#pragma unroll
    for (int o = 1; o < 64; o <<= 1) v += __shfl_xor(v, o);
    return v;
}

__device__ __forceinline__ int win_orig_col(int n) {
    if (n < 1536) return n;
    if (n < 3072) return n + 16;
    if (n < 3088) return n - 3072 + 1536;
    if (n < 3096) return n;
    return -1;
}
template <int MODE>
__device__ __forceinline__ void p0_transpose_item(const float* W, int N, const float* rowscale, bf16* WT, LAS float* scr, int item, int nblk, int lane) {
    const int kb = item / nblk, nb = item % nblk, k0 = 64 * kb, n0 = 32 * nb;
    const int nn = n0 + (lane & 31);
    const int oc = MODE == 0 ? win_orig_col(nn) : nn;
    const float cs = (MODE == 0 && nn < 256) ? 0.125f : 1.0f;
    float wv[32];
#pragma unroll
    for (int i = 0; i < 32; ++i) { const int kk = 2 * i + (lane >> 5); wv[i] = (oc >= 0) ? W[(size_t)(k0 + kk) * N + oc] : 0.f; }
#pragma unroll
    for (int i = 0; i < 32; ++i) { const int kk = 2 * i + (lane >> 5);
        float v = wv[i] * cs; if (rowscale) v *= rowscale[k0 + kk];
        scr[kk * 33 + (lane & 31)] = v; }
    asm volatile("s_waitcnt lgkmcnt(0)" ::: "memory");
    const int c = lane & 7;
#pragma unroll
    for (int j = 0; j < 4; ++j) { const int n = (lane >> 3) + 8 * j; const LAS float* s = scr + (8 * c) * 33 + n;
        u32x4 o; o.x = pk2(s[0 * 33], s[1 * 33]); o.y = pk2(s[2 * 33], s[3 * 33]); o.z = pk2(s[4 * 33], s[5 * 33]); o.w = pk2(s[6 * 33], s[7 * 33]);
        *(u32x4*)(WT + (size_t)(n0 + n) * 1024 + k0 + 8 * c) = o; }
    asm volatile("s_waitcnt lgkmcnt(0)" ::: "memory");
}

__device__ __forceinline__ void quant_u_layer(const Args& a, int l, int gw, int NGW) {
    const int lane = opaque_tid() & 63; unsigned char* ws = a.ws;
    for (int gi = gw; gi < 4096; gi += NGW) {
        const int i1 = gi >> 5, c0 = (gi >> 1) & 15, jh = gi & 1;
        const int eb = (i1 + c0) & 15, el0 = (i1 << 3) | (4 * jh);
        f32x4 x[4][4];
        const float* nw = a.in[I_N2W] + l * DM + lane * 16;
        const f32x4 n0 = *(const f32x4*)nw, n1 = *(const f32x4*)(nw + 4), n2 = *(const f32x4*)(nw + 8), n3 = *(const f32x4*)(nw + 12);
#pragma unroll
        for (int z = 0; z < 4; ++z) { const int e = i1 * 128 + 16 * (4 * jh + z) + c0; const float* src = a.in[I_U] + ((size_t)l * 16384 + e) * DM + lane * 16;
            x[z][0] = *(const f32x4*)src * n0; x[z][1] = *(const f32x4*)(src + 4) * n1; x[z][2] = *(const f32x4*)(src + 8) * n2; x[z][3] = *(const f32x4*)(src + 12) * n3; }
        u32x4 wq[4];
#pragma unroll
        for (int z = 0; z < 4; ++z) {
            float am = 0.f;
#pragma unroll
            for (int j = 0; j < 4; ++j) am = fmaxf(fmaxf(am, fmaxf(fabsf(x[z][j][0]), fabsf(x[z][j][1]))), fmaxf(fabsf(x[z][j][2]), fabsf(x[z][j][3])));
#pragma unroll
            for (int o = 1; o < 64; o <<= 1) am = fmaxf(am, __shfl_xor(am, o));
            const float sc = am > 0.f ? am * (1.0f / 127.0f) : 1.0f, inv = 1.0f / sc;
            unsigned wv[4];
#pragma unroll
            for (int j = 0; j < 4; ++j) { const int q0 = (int)rintf(x[z][j][0] * inv), q1 = (int)rintf(x[z][j][1] * inv), q2 = (int)rintf(x[z][j][2] * inv), q3 = (int)rintf(x[z][j][3] * inv);
                wv[j] = (unsigned)(q0 & 255) | ((unsigned)(q1 & 255) << 8) | ((unsigned)(q2 & 255) << 16) | ((unsigned)(q3 & 255) << 24); }
            wq[z] = (u32x4){wv[0], wv[1], wv[2], wv[3]};
            if (lane == 0) ((float*)(ws + WS_US))[l * 16384 + i1 * 128 + 16 * (4 * jh + z) + c0] = sc;
        }
        u32x4* dst = (u32x4*)(ws + WS_UB + ((size_t)(l * 64 + lane) * 16384 + (size_t)eb * 1024 + el0) * 16);
        dst[0] = wq[0]; dst[1] = wq[1]; dst[2] = wq[2]; dst[3] = wq[3];
    }
}
__device__ __forceinline__ void quant_v_layer(const Args& a, int l, int r_lo, int r_hi, int gw, int NGW) {
    const int lane = opaque_tid() & 63; unsigned char* ws = a.ws;
    for (int row0 = r_lo + gw; row0 < r_hi; row0 += 2 * NGW) {
        f32x4 x[2][4]; int rrv[2];
#pragma unroll
        for (int z = 0; z < 2; ++z) { const int row = row0 + z * NGW; const bool live = row < r_hi; const int rr = l * 16384 + (live ? row : r_lo); rrv[z] = live ? rr : -1;
            const float* src = a.in[I_V] + (size_t)rr * DM + lane * 16;
#pragma unroll
            for (int j = 0; j < 4; ++j) x[z][j] = *(const f32x4*)(src + 4 * j); }
#pragma unroll
        for (int z = 0; z < 2; ++z) {
            float am = 0.f;
#pragma unroll
            for (int j = 0; j < 4; ++j) am = fmaxf(fmaxf(am, fmaxf(fabsf(x[z][j][0]), fabsf(x[z][j][1]))), fmaxf(fabsf(x[z][j][2]), fabsf(x[z][j][3])));
#pragma unroll
            for (int o = 1; o < 64; o <<= 1) am = fmaxf(am, __shfl_xor(am, o));
            const float sc = am > 0.f ? am * (1.0f / 127.0f) : 1.0f, inv = 1.0f / sc;
            unsigned wv[4];
#pragma unroll
            for (int j = 0; j < 4; ++j) { const int q0 = (int)rintf(x[z][j][0] * inv) + 128, q1 = (int)rintf(x[z][j][1] * inv) + 128, q2 = (int)rintf(x[z][j][2] * inv) + 128, q3 = (int)rintf(x[z][j][3] * inv) + 128;
                wv[j] = (unsigned)(q0 & 255) | ((unsigned)(q1 & 255) << 8) | ((unsigned)(q2 & 255) << 16) | ((unsigned)(q3 & 255) << 24); }
            if (rrv[z] >= 0) {
                *(u32x4*)(ws + WS_VB + (size_t)rrv[z] * DM + lane * 16) = (u32x4){wv[0], wv[1], wv[2], wv[3]};
                if (lane == 0) ((float*)(ws + WS_VS))[rrv[z]] = sc; }
        }
    }
}

__device__ __forceinline__ void phase_prologue(const Args& a, LAS unsigned char* lds) {
    const int tid = opaque_tid(), lane = tid & 63, wave = tid >> 6;
    const int G = gridDim.x, gw = blockIdx.x * NWAVES + wave, NGW = G * NWAVES;
    unsigned char* ws = a.ws;
    LAS float* scr = (LAS float*)(lds + wave * 16384);
    {
        constexpr int NB_IN = NIN / 32, IT_IN = 16 * NB_IN, NB_SQ = 32, IT_SQ = 16 * NB_SQ;
        constexpr int PER_LAYER = IT_IN + 2 * IT_SQ;
        for (int it = gw; it < NLAY * PER_LAYER; it += NGW) {
            const int l = it / PER_LAYER; int r = it % PER_LAYER;
            if (r < IT_IN) { p0_transpose_item<0>(a.in[I_WIN] + (size_t)l * DM * 3096, 3096, a.in[I_N1W] + l * DM, (bf16*)(ws + WS_WIN) + (size_t)l * NIN * DM, scr, r, NB_IN, lane); continue; }
            r -= IT_IN;
            if (r < IT_SQ) { p0_transpose_item<1>(a.in[I_WOUT] + (size_t)l * DM * DM, DM, nullptr, (bf16*)(ws + WS_WOUT) + (size_t)l * DM * DM, scr, r, NB_SQ, lane); continue; }
            r -= IT_SQ;
            p0_transpose_item<1>(a.in[I_WQ] + (size_t)l * DM * DM, DM, a.in[I_N2W] + l * DM, (bf16*)(ws + WS_WQ) + (size_t)l * DM * DM, scr, r, NB_SQ, lane);
        }
    }
    {
        float* H = (float*)(ws + WS_H); bf16* HB = (bf16*)(ws + WS_HB); float* SSQ1 = (float*)(ws + WS_SSQ1);
        for (int r = gw; r < MP; r += NGW) {
            f32x4 v[4]; float ss = 0.f;
            const float* src = nullptr;
            if (r < PT) { const int b = r / PL, t = r % PL; src = (t < 16) ? a.in[I_META] + (size_t)t * DM : a.in[I_XP] + ((size_t)b * 2048 + (t - 16)) * DM; }
            else if (r < T) src = a.in[I_XS] + (size_t)(r - PT) * DM;
#pragma unroll
            for (int j = 0; j < 4; ++j) { v[j] = src ? *(const f32x4*)(src + 256 * j + 4 * lane) : (f32x4){0.f, 0.f, 0.f, 0.f};
                ss += (v[j][0] * v[j][0] + v[j][1] * v[j][1]) + (v[j][2] * v[j][2] + v[j][3] * v[j][3]); }
            ss = wave_sum(ss);
#pragma unroll
            for (int j = 0; j < 4; ++j) { *(f32x4*)(H + (size_t)r * DM + 256 * j + 4 * lane) = v[j];
                u32x2 w; w.x = pk2(v[j][0], v[j][1]); w.y = pk2(v[j][2], v[j][3]); *(u32x2*)(HB + (size_t)r * DM + 256 * j + 4 * lane) = w; }
            if (lane == 0) SSQ1[r] = ss;
        }
    }
}

struct ItemG { int g, b, n, h, L, row0, t0, nv; };
__device__ __forceinline__ ItemG decode_gla(int item) {
    ItemG it;
    if (item < NGLA_P) { it.g = 0; it.h = item & 3; const int bn = item >> 2; it.n = bn % NCH; it.b = bn / NCH; it.L = PL; it.row0 = it.b * PL; }
    else { const int j = item - NGLA_P; it.g = 1; it.h = j & 3; it.b = j >> 2; it.n = 0; it.L = SL; it.row0 = PT + it.b * SL; }
    it.t0 = it.n * 64; it.nv = min(64, it.L - it.t0); return it;
}
__device__ __forceinline__ ItemG decode_ssd(int item) {
    ItemG it;
    if (item < NSSD_P) { it.g = 0; it.h = item & 7; const int bn = item >> 3; it.n = bn % NCH; it.b = bn / NCH; it.L = PL; it.row0 = it.b * PL; }
    else { const int j = item - NSSD_P; it.g = 1; it.h = j & 7; it.b = j >> 3; it.n = 0; it.L = SL; it.row0 = PT + it.b * SL; }
    it.t0 = it.n * 64; it.nv = min(64, it.L - it.t0); return it;
}
typedef short bf16x8 __attribute__((ext_vector_type(8)));
__device__ __forceinline__ f32x4 mfma16(bf16x8 a, bf16x8 b, f32x4 c) { return __builtin_amdgcn_mfma_f32_16x16x32_bf16(a, b, c, 0, 0, 0); }
__device__ __forceinline__ float wave_scan_incl(float v, int lane) {
    (void)lane;
#define WS_DPP(x, ctrl, rmask, bc) __int_as_float(__builtin_amdgcn_update_dpp(0, __float_as_int(x), ctrl, rmask, 0xF, bc))
    v += WS_DPP(v, 0x111, 0xF, true);
    v += WS_DPP(v, 0x112, 0xF, true);
    v += WS_DPP(v, 0x114, 0xF, true);
    v += WS_DPP(v, 0x118, 0xF, true);
    v += WS_DPP(v, 0x142, 0xA, false);
    v += WS_DPP(v, 0x143, 0xC, false);
#undef WS_DPP
    return v;
}
__device__ __forceinline__ void unpack8(const u32x4 r, float* o) { o[0] = bflo(r.x); o[1] = bfhi(r.x); o[2] = bflo(r.y); o[3] = bfhi(r.y); o[4] = bflo(r.z); o[5] = bfhi(r.z); o[6] = bflo(r.w); o[7] = bfhi(r.w); }
__device__ __forceinline__ u32x4 pack8(const float* f) { return (u32x4){pk2(f[0], f[1]), pk2(f[2], f[3]), pk2(f[4], f[5]), pk2(f[6], f[7])}; }
__device__ __forceinline__ float softplusf(float x) { return fmaxf(x, 0.f) + __logf(1.0f + __expf(-fabsf(x))); }

__device__ __forceinline__ int tsw(int r, int t) { return r * 72 + (((((t >> 3) ^ (r >> 4)) & 7) << 3) | (t & 7)); }
__device__ __forceinline__ int fsw(int tile, int ks, int q) { return (((4 * ks + q) ^ tile) & 7) << 3; }
__device__ __forceinline__ void conv_silu8(const Args& a, int l, const ItemG& it, int ts, int cc0, float* o) {
    const bf16* P = (const bf16*)(a.ws + WS_PROJ);
    const float* cbp = a.in[I_CONVB] + l * 1024 + cc0;
    const f32x4 b0 = *(const f32x4*)cbp, b1 = *(const f32x4*)(cbp + 4);
    float acc[8] = {b0[0], b0[1], b0[2], b0[3], b1[0], b1[1], b1[2], b1[3]};
#pragma unroll
    for (int i = 0; i < 4; ++i) {
        const int tt = ts - 3 + i; float xv[8];
        if (tt >= 0) { const u32x4 r = *(const u32x4*)(P + (size_t)(it.row0 + tt) * NIN + CX + cc0); unpack8(r, xv); }
        else if (it.g) { const float* sp = a.in[I_SCONV] + ((size_t)(l * SB + it.b) * 3 + (tt + 3)) * 1024 + cc0; const f32x4 s0 = *(const f32x4*)sp, s1 = *(const f32x4*)(sp + 4);
            xv[0] = s0[0]; xv[1] = s0[1]; xv[2] = s0[2]; xv[3] = s0[3]; xv[4] = s1[0]; xv[5] = s1[1]; xv[6] = s1[2]; xv[7] = s1[3]; }
        else {
#pragma unroll
            for (int j = 0; j < 8; ++j) xv[j] = 0.f; }
        const float* wp = a.in[I_CONVW] + (size_t)(l * 4 + i) * 1024 + cc0; const f32x4 w0 = *(const f32x4*)wp, w1 = *(const f32x4*)(wp + 4);
        acc[0] += w0[0] * xv[0]; acc[1] += w0[1] * xv[1]; acc[2] += w0[2] * xv[2]; acc[3] += w0[3] * xv[3];
        acc[4] += w1[0] * xv[4]; acc[5] += w1[1] * xv[5]; acc[6] += w1[2] * xv[6]; acc[7] += w1[3] * xv[7];
    }
#pragma unroll
    for (int j = 0; j < 8; ++j) o[j] = siluf(acc[j]);
}

__device__ __forceinline__ void gates_load(const Args& a, int l, const ItemG& it, float* fl, float* wg, float* bg, int tid) {
    const bf16* P = (const bf16*)(a.ws + WS_PROJ) + (size_t)(it.row0 + it.t0) * NIN;
    if (tid < 128) {
        const int t = tid >> 1, r0 = (tid & 1) * 8;
        u32x4 r = (u32x4){0u, 0u, 0u, 0u};
        if (t < it.nv) r = *(const u32x4*)(P + (size_t)t * NIN + CF + r0);
        unpack8(r, fl + t * 16 + r0);
    }
    const float* W = a.in[I_WGK2] + (size_t)l * 16 * 256;
    for (int i = tid; i < 1024; i += NTHR) { const int r = i >> 6, d = i & 63; wg[i] = W[r * 256 + it.h * 64 + d]; }
    if (tid < 64) bg[tid] = a.in[I_BGK2][l * 256 + it.h * 64 + tid];
}
__device__ __forceinline__ void gates_gk(const ItemG& it, float* bc, const float* fl, const float* wg, const float* bg, int tid) {
    const int d = tid & 63, t0 = tid >> 6;
    float wr[16];
#pragma unroll
    for (int r = 0; r < 16; ++r) wr[r] = wg[r * 64 + d];
    const float b0 = bg[d];
#pragma unroll
    for (int i = 0; i < 8; ++i) { const int t = t0 + 8 * i;
        const f32x4 f0 = *(const f32x4*)(fl + t * 16), f1 = *(const f32x4*)(fl + t * 16 + 4), f2 = *(const f32x4*)(fl + t * 16 + 8), f3 = *(const f32x4*)(fl + t * 16 + 12);
        float x = b0;
#pragma unroll
        for (int r = 0; r < 4; ++r) { x += f0[r] * wr[r]; x += f1[r] * wr[4 + r]; x += f2[r] * wr[8 + r]; x += f3[r] * wr[12 + r]; }
        const float ls = fminf(x, 0.f) - __logf(1.0f + __expf(-fabsf(x)));
        bc[t * 65 + d] = (t < it.nv) ? ls * (1.0f / 16.0f) : 0.f; }
}
__device__ __forceinline__ void gates_scan(float* bc, int tid) {
    const int lane = tid & 63, w = tid >> 6;
#pragma unroll
    for (int i = 0; i < 8; ++i) { const int d = w * 8 + i; float v = bc[lane * 65 + d]; v = wave_scan_incl(v, lane); bc[lane * 65 + d] = v; }
}

template <int NB>
__device__ __forceinline__ void r1_gla_b(const Args& a, int l, int item0, float* lds) {
    const int tid = opaque_tid(), lane = tid & 63, w = tid >> 6, c = lane & 15, q = lane >> 4;
    constexpr int SZ = 34304;
    const int t = tid >> 3, j8 = tid & 7;
    ItemG it[NB]; u32x4 rk[NB], rv[NB][2];
#pragma unroll
    for (int u = 0; u < NB; ++u) {
        it[u] = decode_gla(item0 + u);
        float* bc = (float*)((unsigned char*)lds + u * SZ); float* fl = bc + 64 * 65; float* wg = fl + 1024; float* bg = wg + 1024;
        const bf16* P = (const bf16*)(a.ws + WS_PROJ) + (size_t)(it[u].row0 + it[u].t0) * NIN;
        rk[u] = (u32x4){0u, 0u, 0u, 0u}; rv[u][0] = rk[u]; rv[u][1] = rk[u];
        if (t < it[u].nv) { rk[u] = *(const u32x4*)(P + (size_t)t * NIN + CK + it[u].h * 64 + j8 * 8);
            rv[u][0] = *(const u32x4*)(P + (size_t)t * NIN + CV + it[u].h * 128 + j8 * 16); rv[u][1] = *(const u32x4*)(P + (size_t)t * NIN + CV + it[u].h * 128 + j8 * 16 + 8); }
        gates_load(a, l, it[u], fl, wg, bg, tid);
    }
    __syncthreads();
#pragma unroll
    for (int u = 0; u < NB; ++u) { float* bc = (float*)((unsigned char*)lds + u * SZ); gates_gk(it[u], bc, bc + 64 * 65, bc + 64 * 65 + 1024, bc + 64 * 65 + 2048, tid); }
    __syncthreads();
#pragma unroll
    for (int u = 0; u < NB; ++u) gates_scan((float*)((unsigned char*)lds + u * SZ), tid);
    __syncthreads();
#pragma unroll
    for (int u = 0; u < NB; ++u) {
        float* bc = (float*)((unsigned char*)lds + u * SZ); bf16* KT = (bf16*)(bc + 64 * 65 + 2048 + 64);
        const int d0 = j8 * 8;
        float kf[8], bv[8]; unpack8(rk[u], kf);
#pragma unroll
        for (int i = 0; i < 8; ++i) { const int d = d0 + i; bv[i] = bc[t * 65 + d]; KT[tsw(d, t)] = (bf16)f2bf(kf[i] * __expf(bc[63 * 65 + d] - bv[i])); }
        float* BCg = (float*)(a.ws + WS_BC) + (size_t)(item0 + u) * 4096 + t * 64 + d0;
        *(f32x4*)BCg = (f32x4){bv[0], bv[1], bv[2], bv[3]}; *(f32x4*)(BCg + 4) = (f32x4){bv[4], bv[5], bv[6], bv[7]};
        if (tid < 64) ((float*)(a.ws + WS_DG))[(size_t)(item0 + u) * 64 + tid] = __expf(bc[63 * 65 + tid]);
    }
    __syncthreads();
#pragma unroll
    for (int u = 0; u < NB; ++u) {
        bf16* VT = (bf16*)((unsigned char*)lds + u * SZ);
        const unsigned wv[8] = {rv[u][0].x, rv[u][0].y, rv[u][0].z, rv[u][0].w, rv[u][1].x, rv[u][1].y, rv[u][1].z, rv[u][1].w};
#pragma unroll
        for (int i = 0; i < 16; ++i) VT[tsw(j8 * 16 + i, t)] = (bf16)((i & 1) ? (wv[i >> 1] >> 16) : (wv[i >> 1] & 0xffffu));
    }
    __syncthreads();
#pragma unroll
    for (int u = 0; u < NB; ++u) {
        const bf16* VT = (const bf16*)((unsigned char*)lds + u * SZ); const bf16* KT = (const bf16*)((unsigned char*)lds + u * SZ + 25088);
        const int nks = (it[u].nv + 31) >> 5;
        bf16* SG = (bf16*)(a.ws + WS_SG) + (size_t)(item0 + u) * 8192;
        bf16x8 vf[2];
#pragma unroll
        for (int ks = 0; ks < 2; ++ks) vf[ks] = *(const bf16x8*)(VT + (16 * w + c) * 72 + fsw(w, ks, q));
#pragma unroll
        for (int dt = 0; dt < 4; ++dt) {
            f32x4 acc = (f32x4){0.f, 0.f, 0.f, 0.f};
#pragma unroll
            for (int ks = 0; ks < 2; ++ks) if (ks < nks) { const bf16x8 af = *(const bf16x8*)(KT + (16 * dt + c) * 72 + fsw(dt, ks, q)); acc = mfma16(vf[ks], af, acc); }
            *(u32x2*)(SG + (16 * dt + c) * 128 + 16 * w + 4 * q) = (u32x2){pk2(acc[0], acc[1]), pk2(acc[2], acc[3])};
        }
    }
}

template <int NB>
__device__ __forceinline__ void r1_ssd_b(const Args& a, int l, int item0, float* lds) {
    const int tid = opaque_tid(), lane = tid & 63, w = tid >> 6, c = lane & 15, q = lane >> 4;
    constexpr int SZ = 28160;
    static_assert(NB <= 8, "one wave per item scans dt");
    const int t = tid >> 3, j8 = tid & 7;
    ItemG it[NB]; float xv[NB][8], bv[NB][16];
#pragma unroll
    for (int u = 0; u < NB; ++u) {
        it[u] = decode_ssd(item0 + u);
        const int hd = it[u].h, gr = hd >> 2;
        float* dtv = (float*)((unsigned char*)lds + u * SZ);
        if (t < it[u].nv) { conv_silu8(a, l, it[u], it[u].t0 + t, hd * 64 + j8 * 8, xv[u]); conv_silu8(a, l, it[u], it[u].t0 + t, 512 + gr * 128 + j8 * 16, bv[u]); conv_silu8(a, l, it[u], it[u].t0 + t, 512 + gr * 128 + j8 * 16 + 8, bv[u] + 8); }
        else {
#pragma unroll
            for (int i = 0; i < 8; ++i) { xv[u][i] = 0.f; bv[u][i] = 0.f; bv[u][8 + i] = 0.f; } }
        if (tid < 64) { const bf16* P = (const bf16*)(a.ws + WS_PROJ);
            dtv[tid] = (tid < it[u].nv) ? softplusf(bf2f(P[(size_t)(it[u].row0 + it[u].t0 + tid) * NIN + CDT + hd]) + a.in[I_DTB][l * 8 + hd]) : 0.f; }
    }
    __syncthreads();
#pragma unroll
    for (int u = 0; u < NB; ++u) if (w == u) { float* dtv = (float*)((unsigned char*)lds + u * SZ); const float aa = -__expf(a.in[I_ALOG][l * 8 + it[u].h]); dtv[64 + lane] = wave_scan_incl(dtv[lane] * aa, lane); }
    __syncthreads();
#pragma unroll
    for (int u = 0; u < NB; ++u) {
        float* dtv = (float*)((unsigned char*)lds + u * SZ); const float* cum = dtv + 64; bf16* XT = (bf16*)(dtv + 128); bf16* BT = XT + 64 * 72;
        const float sc = __expf(cum[63] - cum[t]) * dtv[t];
#pragma unroll
        for (int i = 0; i < 8; ++i) XT[(j8 * 8 + i) * 72 + t] = (bf16)f2bf(xv[u][i] * sc);
#pragma unroll
        for (int i = 0; i < 16; ++i) BT[(j8 * 16 + i) * 72 + t] = (bf16)f2bf(bv[u][i]);
    }
    __syncthreads();
#pragma unroll
    for (int u = 0; u < NB; ++u) {
        const float* dtv = (const float*)((unsigned char*)lds + u * SZ); const bf16* XT = (const bf16*)(dtv + 128); const bf16* BT = XT + 64 * 72;
        const int nks = (it[u].nv + 31) >> 5;
        float* SS = (float*)(a.ws + WS_SS) + (size_t)(item0 + u) * 8192;
#pragma unroll
        for (int pt = 0; pt < 4; ++pt) {
            f32x4 acc = (f32x4){0.f, 0.f, 0.f, 0.f};
#pragma unroll
            for (int ks = 0; ks < 2; ++ks) if (ks < nks) {
                const bf16x8 af = *(const bf16x8*)(XT + (16 * pt + c) * 72 + 32 * ks + 8 * q);
                const bf16x8 bfr = *(const bf16x8*)(BT + (16 * w + c) * 72 + 32 * ks + 8 * q);
                acc = mfma16(af, bfr, acc); }
#pragma unroll
            for (int r = 0; r < 4; ++r) SS[(16 * pt + 4 * q + r) * 128 + 16 * w + c] = acc[r];
        }
        if (tid == 0) ((float*)(a.ws + WS_DS))[item0 + u] = __expf(dtv[64 + 63]);
    }
    __syncthreads();
}

__device__ __forceinline__ void conv_taps(const Args& a, int l, const ItemG& it, int ts, int cc0, u32x4 (&raw)[4]) {
    const bf16* P = (const bf16*)(a.ws + WS_PROJ);
#pragma unroll
    for (int i = 0; i < 4; ++i) {
        const int tt = ts - 3 + i;
        if (tt >= 0) raw[i] = *(const u32x4*)(P + (size_t)(it.row0 + tt) * NIN + CX + cc0);
        else if (it.g) { const float* sp = a.in[I_SCONV] + ((size_t)(l * SB + it.b) * 3 + (tt + 3)) * 1024 + cc0; const f32x4 s0 = *(const f32x4*)sp, s1 = *(const f32x4*)(sp + 4);
            raw[i] = (u32x4){pk2(s0[0], s0[1]), pk2(s0[2], s0[3]), pk2(s1[0], s1[1]), pk2(s1[2], s1[3])}; }
        else raw[i] = (u32x4){0u, 0u, 0u, 0u};
    }
}
__device__ __forceinline__ void conv_eval(const u32x4 (&raw)[4], int cc0, const float* cwl, float* o) {
    const f32x4 b0 = *(const f32x4*)(cwl + 4096 + cc0), b1 = *(const f32x4*)(cwl + 4096 + cc0 + 4);
    float acc[8] = {b0[0], b0[1], b0[2], b0[3], b1[0], b1[1], b1[2], b1[3]};
#pragma unroll
    for (int i = 0; i < 4; ++i) {
        float xv[8]; unpack8(raw[i], xv);
        const f32x4 w0 = *(const f32x4*)(cwl + i * 1024 + cc0), w1 = *(const f32x4*)(cwl + i * 1024 + cc0 + 4);
        acc[0] += w0[0] * xv[0]; acc[1] += w0[1] * xv[1]; acc[2] += w0[2] * xv[2]; acc[3] += w0[3] * xv[3];
        acc[4] += w1[0] * xv[4]; acc[5] += w1[1] * xv[5]; acc[6] += w1[2] * xv[6]; acc[7] += w1[3] * xv[7];
    }
#pragma unroll
    for (int j = 0; j < 8; ++j) o[j] = siluf(acc[j]);
}
constexpr int K3_OFF = 147456;
constexpr int K1_OFF = MISC_OFF + 128;
constexpr int CWL_OFF = 143104;

__device__ __forceinline__ void r1_ssd_grp(const Args& a, int l, int gitem, float* lds) {
    const int tid = opaque_tid(), lane = tid & 63, w = tid >> 6, c = lane & 15, q = lane >> 4;
    ItemG it; const int gr = gitem & 1; const int bn = gitem >> 1;
    if (bn < PB * NCH) { it.g = 0; it.n = bn % NCH; it.b = bn / NCH; it.L = PL; it.row0 = it.b * PL; }
    else { it.g = 1; it.b = bn - PB * NCH; it.n = 0; it.L = SL; it.row0 = PT + it.b * SL; }
    it.h = 0; it.t0 = it.n * 64; it.nv = min(64, it.L - it.t0);
    const int item0 = it.g ? NSSD_P + it.b * 8 + gr * 4 : (it.b * NCH + it.n) * 8 + gr * 4;
    unsigned char* lb = (unsigned char*)lds;
    float* dtv4 = (float*)lb; float* cum4 = dtv4 + 256;
    bf16* XT4 = (bf16*)(lb + 2048); bf16* BT = XT4 + 256 * 72;
    const float* cwl = (const float*)(lb + CWL_OFF);
    const int t = tid >> 3, j8 = tid & 7;
    const int nks = (it.nv + 31) >> 5;
    bf16* XC = (bf16*)(a.ws + WS_XC) + (size_t)(it.row0 + it.t0 + t) * 1024;
    if (tid < 256) { const int h4 = tid >> 6, tq = tid & 63; const bf16* P = (const bf16*)(a.ws + WS_PROJ);
        dtv4[tid] = (tq < it.nv) ? softplusf(bf2f(P[(size_t)(it.row0 + it.t0 + tq) * NIN + CDT + gr * 4 + h4]) + a.in[I_DTB][l * 8 + gr * 4 + h4]) : 0.f; }
    float xv[4][8];
    {
        const int cb0 = 512 + gr * 128 + j8 * 16, cc0 = 768 + gr * 128 + j8 * 16;
        float bv[16];
        if (t < it.nv) {
            u32x4 raw[4][4], rawx[4];
            conv_taps(a, l, it, it.t0 + t, cb0, raw[0]); conv_taps(a, l, it, it.t0 + t, cb0 + 8, raw[1]); conv_taps(a, l, it, it.t0 + t, cc0, raw[2]); conv_taps(a, l, it, it.t0 + t, cc0 + 8, raw[3]);
            __builtin_amdgcn_sched_barrier(0);
            float cv[16];
            conv_taps(a, l, it, it.t0 + t, (gr * 4 + 0) * 64 + j8 * 8, rawx);
            conv_eval(raw[0], cb0, cwl, bv);
            __builtin_amdgcn_sched_barrier(0);
            conv_taps(a, l, it, it.t0 + t, (gr * 4 + 1) * 64 + j8 * 8, raw[0]);
            conv_eval(raw[1], cb0 + 8, cwl, bv + 8);
            *(u32x4*)(XC + cb0) = pack8(bv); *(u32x4*)(XC + cb0 + 8) = pack8(bv + 8);
            __builtin_amdgcn_sched_barrier(0);
            conv_taps(a, l, it, it.t0 + t, (gr * 4 + 2) * 64 + j8 * 8, raw[1]);
            conv_eval(raw[2], cc0, cwl, cv);
            __builtin_amdgcn_sched_barrier(0);
            conv_taps(a, l, it, it.t0 + t, (gr * 4 + 3) * 64 + j8 * 8, raw[2]);
            conv_eval(raw[3], cc0 + 8, cwl, cv + 8);
            *(u32x4*)(XC + cc0) = pack8(cv); *(u32x4*)(XC + cc0 + 8) = pack8(cv + 8);
            __builtin_amdgcn_sched_barrier(0);
            conv_eval(rawx, (gr * 4 + 0) * 64 + j8 * 8, cwl, xv[0]); *(u32x4*)(XC + (gr * 4 + 0) * 64 + j8 * 8) = pack8(xv[0]);
            conv_eval(raw[0], (gr * 4 + 1) * 64 + j8 * 8, cwl, xv[1]); *(u32x4*)(XC + (gr * 4 + 1) * 64 + j8 * 8) = pack8(xv[1]);
            conv_eval(raw[1], (gr * 4 + 2) * 64 + j8 * 8, cwl, xv[2]); *(u32x4*)(XC + (gr * 4 + 2) * 64 + j8 * 8) = pack8(xv[2]);
            conv_eval(raw[2], (gr * 4 + 3) * 64 + j8 * 8, cwl, xv[3]); *(u32x4*)(XC + (gr * 4 + 3) * 64 + j8 * 8) = pack8(xv[3]);
        } else {
#pragma unroll
            for (int i = 0; i < 16; ++i) bv[i] = 0.f;
#pragma unroll
            for (int h4 = 0; h4 < 4; ++h4)
#pragma unroll
                for (int i = 0; i < 8; ++i) xv[h4][i] = 0.f; }
#pragma unroll
        for (int i = 0; i < 16; ++i) BT[tsw(j8 * 16 + i, t)] = (bf16)f2bf(bv[i]);
    }
    __builtin_amdgcn_sched_barrier(0);
    __syncthreads();
    if (w < 4) { const float aa = ((const float*)(lb + K1_OFF))[gr * 4 + w]; cum4[w * 64 + lane] = wave_scan_incl(dtv4[w * 64 + lane] * aa, lane); }
    __syncthreads();
#pragma unroll
    for (int h4 = 0; h4 < 4; ++h4) { const float sc = __expf(cum4[h4 * 64 + 63] - cum4[h4 * 64 + t]) * dtv4[h4 * 64 + t];
#pragma unroll
        for (int i = 0; i < 8; ++i) XT4[tsw(h4 * 64 + j8 * 8 + i, t)] = (bf16)f2bf(xv[h4][i] * sc); }
    __syncthreads();
    bf16x8 bfr[2];
#pragma unroll
    for (int ks = 0; ks < 2; ++ks) bfr[ks] = *(const bf16x8*)(BT + (16 * w + c) * 72 + fsw(w, ks, q));
#pragma unroll
    for (int h4 = 0; h4 < 4; ++h4) {
        bf16* SS = (bf16*)(a.ws + WS_SS) + (size_t)(item0 + h4) * 8192;
#pragma unroll
        for (int pt = 0; pt < 4; ++pt) {
            f32x4 acc = (f32x4){0.f, 0.f, 0.f, 0.f};
#pragma unroll
            for (int ks = 0; ks < 2; ++ks) if (ks < nks) acc = mfma16(bfr[ks], *(const bf16x8*)(XT4 + (h4 * 64 + 16 * pt + c) * 72 + fsw(4 * h4 + pt, ks, q)), acc);
            *(u32x2*)(SS + (16 * pt + c) * 128 + 16 * w + 4 * q) = (u32x2){pk2(acc[0], acc[1]), pk2(acc[2], acc[3])};
        }
    }
    if (tid < 4) ((float*)(a.ws + WS_DS))[item0 + tid] = __expf(cum4[tid * 64 + 63]);
}

#define RAW_HANDOFF_BARRIER() do { asm volatile("s_waitcnt lgkmcnt(0)" ::: "memory"); __builtin_amdgcn_s_barrier(); asm volatile("" ::: "memory"); } while (0)
__device__ __forceinline__ int q_next(unsigned* ctr, volatile unsigned* slot) {
    if (threadIdx.x == 0) *slot = __hip_atomic_fetch_add(ctr, 1u, __ATOMIC_RELAXED, __HIP_MEMORY_SCOPE_AGENT);
    __syncthreads();
    const int v = (int)*slot;
    __syncthreads();
    return v;
}
constexpr int R1_NB = 1;
__device__ __forceinline__ void r1_stage(const Args& a, int l, float* lds) {
    __syncthreads();
    float* cwl = (float*)((unsigned char*)lds + CWL_OFF); const int tid = opaque_tid();
    for (int i = tid; i < 4096; i += NTHR) cwl[i] = a.in[I_CONVW][(size_t)l * 4096 + i];
    for (int i = tid; i < 1024; i += NTHR) cwl[4096 + i] = a.in[I_CONVB][l * 1024 + i];
    if (tid < 8) ((float*)((unsigned char*)lds + K1_OFF))[tid] = -__expf(a.in[I_ALOG][l * 8 + tid]);
}
__device__ __forceinline__ void phase_r1(const Args& a, int l, float* lds, int rep) {
    static_assert(NSSD % R1_NB == 0 && NGLA % R1_NB == 0, "batches do not straddle kinds");
    unsigned* ctr = (unsigned*)(a.ws + WS_CTL) + CW_Q + ((l * 8 + 1) * 4 + rep) * 64;
    volatile unsigned* slot = (volatile unsigned*)((unsigned char*)lds + MISC_OFF) + 16;
    if (a.ph_hi - a.ph_lo == 1) { r1_stage(a, l, lds); __syncthreads(); }
    constexpr int NSG = (PB * NCH + SB) * 2;
    for (int u = blockIdx.x; u < NSG + NGLA / R1_NB; ) {
        unsigned nxt = 0u;
        if (threadIdx.x == 0) nxt = gridDim.x + __hip_atomic_fetch_add(ctr, 1u, __ATOMIC_RELAXED, __HIP_MEMORY_SCOPE_AGENT);
        if (u < NSG) r1_ssd_grp(a, l, u, lds); else r1_gla_b<R1_NB>(a, l, (u - NSG) * R1_NB, lds);
        if (threadIdx.x == 0) *slot = nxt;
        RAW_HANDOFF_BARRIER();
        u = (int)*slot;
    }
    const bf16* P = (const bf16*)(a.ws + WS_PROJ);
    const int gt = blockIdx.x * NTHR + opaque_tid(), GT = gridDim.x * NTHR;
    for (int i = gt; i < (PB + SB) * 3 * 128; i += GT) {
        const int c8 = (i & 127) * 8, j = (i >> 7) % 3, b = i / 384;
        const bf16* src; float* dst;
        if (b < PB) { src = P + (size_t)(b * PL + PL - 3 + j) * NIN + CX + c8; dst = a.out + O_CP + ((size_t)(l * PB + b) * 3 + j) * 1024 + c8; }
        else { const int sb = b - PB; src = P + (size_t)(PT + sb * SL + SL - 3 + j) * NIN + CX + c8; dst = a.out + O_CS + ((size_t)(l * SB + sb) * 3 + j) * 1024 + c8; }
        float f[8]; unpack8(*(const u32x4*)src, f);
        *(f32x4*)dst = (f32x4){f[0], f[1], f[2], f[3]}; *(f32x4*)(dst + 4) = (f32x4){f[4], f[5], f[6], f[7]};
    }
}

__device__ __forceinline__ void phase_r2(const Args& a, int l) {
    const size_t gt = (size_t)blockIdx.x * NTHR + opaque_tid(), GT = (size_t)gridDim.x * NTHR;
    constexpr size_t N0 = (size_t)PB * 4 * 2048, N1 = (size_t)PB * 8 * 2048, N2 = (size_t)SB * 4 * 2048, N3 = (size_t)SB * 8 * 2048;
    bf16* SG = (bf16*)(a.ws + WS_SG); float* DG = (float*)(a.ws + WS_DG); bf16* SS = (bf16*)(a.ws + WS_SS); float* DS = (float*)(a.ws + WS_DS);
    typedef float f32x2 __attribute__((ext_vector_type(2)));
    for (size_t i = gt; i < 2 * (N0 + N1); i += GT) {
        bf16* p; const float* dp; size_t pstride, dstride; float* outp;
        if (i < 2 * N0) {
            const int e2 = (int)(i & 4095), bh = (int)(i >> 12), h = bh & 3, b = bh >> 2, d = e2 >> 6;
            const size_t item0 = (size_t)(b * NCH) * 4 + h;
            p = SG + item0 * 8192 + e2 * 2; pstride = 4 * 8192; dp = DG + item0 * 64 + d; dstride = 4 * 64;
            outp = a.out + O_GP + ((size_t)(l * PB + b) * 4 + h) * 8192 + e2 * 2;
        } else {
            const size_t j = i - 2 * N0; const int e2 = (int)(j & 4095), bh = (int)(j >> 12), hd = bh & 7, b = bh >> 3;
            const size_t item0 = (size_t)(b * NCH) * 8 + hd;
            p = SS + item0 * 8192 + e2 * 2; pstride = 8 * 8192; dp = DS + item0; dstride = 8;
            outp = a.out + O_SP + ((size_t)(l * PB + b) * 8 + hd) * 8192 + e2 * 2;
        }
        f32x2 s = (f32x2){0.f, 0.f};
        {
            unsigned loc[NCH]; float dec[NCH];
#pragma unroll
            for (int k = 0; k < NCH; ++k) { loc[k] = *(const unsigned*)(p + (size_t)k * pstride); dec[k] = dp[(size_t)k * dstride]; }
#pragma unroll
            for (int k = 0; k < NCH; ++k) { *(unsigned*)(p + (size_t)k * pstride) = pk2(s[0], s[1]); s = s * dec[k] + (f32x2){__uint_as_float(loc[k] << 16), __uint_as_float(loc[k] & 0xffff0000u)}; }
        }
        *(f32x2*)outp = s;
    }
    for (size_t i0 = gt; i0 < N2 + N3; i0 += 4 * GT) {
        f32x4 s0[4]; u32x2 loc[4]; float dec[4]; float* outp[4];
#pragma unroll
        for (int k = 0; k < 4; ++k) { const size_t i = i0 + (size_t)k * GT; outp[k] = nullptr;
            if (i < N2) {
                const int e4 = (int)(i & 2047), bh = (int)(i >> 11), d = e4 >> 5; const size_t item = NGLA_P + bh;
                s0[k] = *(const f32x4*)(a.in[I_SGLA] + ((size_t)l * SB * 4 + bh) * 8192 + e4 * 4);
                loc[k] = *(const u32x2*)(SG + item * 8192 + e4 * 4); dec[k] = DG[item * 64 + d];
                outp[k] = a.out + O_GS + ((size_t)l * SB * 4 + bh) * 8192 + e4 * 4;
            } else if (i < N2 + N3) {
                const size_t j = i - N2; const int e4 = (int)(j & 2047), bh = (int)(j >> 11); const size_t item = NSSD_P + bh;
                s0[k] = *(const f32x4*)(a.in[I_SSSM] + ((size_t)l * SB * 8 + bh) * 8192 + e4 * 4);
                loc[k] = *(const u32x2*)(SS + item * 8192 + e4 * 4); dec[k] = DS[item];
                outp[k] = a.out + O_SS + ((size_t)l * SB * 8 + bh) * 8192 + e4 * 4;
            } }
#pragma unroll
        for (int k = 0; k < 4; ++k) if (outp[k]) *(f32x4*)outp[k] = s0[k] * dec[k] + (f32x4){__uint_as_float(loc[k].x << 16), __uint_as_float(loc[k].x & 0xffff0000u), __uint_as_float(loc[k].y << 16), __uint_as_float(loc[k].y & 0xffff0000u)};
    }
}

template <int NB>
__device__ __forceinline__ void r3_gla_b(const Args& a, int l, int item0, float* lds) {
    const int tid = opaque_tid(), lane = tid & 63, w = tid >> 6, c = lane & 15, q = lane >> 4;
    constexpr int SZ = 64512;
    const int t = tid >> 3, j8 = tid & 7;
    ItemG it[NB]; u32x4 rg[NB][2];
#pragma unroll
    for (int u = 0; u < NB; ++u) {
        it[u] = decode_gla(item0 + u);
        bf16* QS = (bf16*)((unsigned char*)lds + u * SZ); bf16* KS = QS + 64 * 72; bf16* VT = KS + 2 * 64 * 72; bf16* ST = VT + 128 * 72;
        const bf16* P = (const bf16*)(a.ws + WS_PROJ) + (size_t)(it[u].row0 + it[u].t0) * NIN;
        const u32x4 z4 = (u32x4){0u, 0u, 0u, 0u};
        u32x4 rk = z4, rq = z4, rv0 = z4, rv1 = z4; rg[u][0] = z4; rg[u][1] = z4;
        if (t < it[u].nv) { rk = *(const u32x4*)(P + (size_t)t * NIN + CK + it[u].h * 64 + j8 * 8); rq = *(const u32x4*)(P + (size_t)t * NIN + CQ + it[u].h * 64 + j8 * 8);
            rv0 = *(const u32x4*)(P + (size_t)t * NIN + CV + it[u].h * 128 + j8 * 16); rv1 = *(const u32x4*)(P + (size_t)t * NIN + CV + it[u].h * 128 + j8 * 16 + 8);
            rg[u][0] = *(const u32x4*)(P + (size_t)t * NIN + CG + it[u].h * 128 + j8 * 16); rg[u][1] = *(const u32x4*)(P + (size_t)t * NIN + CG + it[u].h * 128 + j8 * 16 + 8); }
        const float* BCg = (const float*)(a.ws + WS_BC) + (size_t)(item0 + u) * 4096 + t * 64 + j8 * 8;
        const f32x4 b0 = *(const f32x4*)BCg, b1 = *(const f32x4*)(BCg + 4);
        u32x4 sw0, sw1;
        if (it[u].g) { const float* sp = a.in[I_SGLA] + ((size_t)(l * SB + it[u].b) * 4 + it[u].h) * 8192 + t * 128 + j8 * 16;
            const f32x4 s0 = *(const f32x4*)sp, s1 = *(const f32x4*)(sp + 4), s2 = *(const f32x4*)(sp + 8), s3 = *(const f32x4*)(sp + 12);
            sw0 = (u32x4){pk2(s0[0], s0[1]), pk2(s0[2], s0[3]), pk2(s1[0], s1[1]), pk2(s1[2], s1[3])}; sw1 = (u32x4){pk2(s2[0], s2[1]), pk2(s2[2], s2[3]), pk2(s3[0], s3[1]), pk2(s3[2], s3[3])};
        } else { const bf16* sp = (const bf16*)(a.ws + WS_SG) + (size_t)(item0 + u) * 8192 + t * 128 + j8 * 16; sw0 = *(const u32x4*)sp; sw1 = *(const u32x4*)(sp + 8); }
        {
            const float bb[8] = {b0[0], b0[1], b0[2], b0[3], b1[0], b1[1], b1[2], b1[3]};
            float kf[8], qf[8]; unpack8(rk, kf); unpack8(rq, qf);
#pragma unroll
            for (int i = 0; i < 8; ++i) { qf[i] *= __expf(bb[i]); kf[i] *= __expf(-bb[i]); }
            *(u32x4*)(QS + t * 72 + j8 * 8) = pack8(qf); *(u32x4*)(KS + t * 72 + j8 * 8) = pack8(kf);
        }
        {
            const unsigned wv[8] = {rv0.x, rv0.y, rv0.z, rv0.w, rv1.x, rv1.y, rv1.z, rv1.w};
            const unsigned sv[8] = {sw0.x, sw0.y, sw0.z, sw0.w, sw1.x, sw1.y, sw1.z, sw1.w};
#pragma unroll
            for (int i = 0; i < 16; ++i) { VT[tsw(j8 * 16 + i, t)] = (bf16)((i & 1) ? (wv[i >> 1] >> 16) : (wv[i >> 1] & 0xffffu)); ST[tsw(j8 * 16 + i, t)] = (bf16)((i & 1) ? (sv[i >> 1] >> 16) : (sv[i >> 1] & 0xffffu)); }
        }
    }
    __syncthreads();
#pragma unroll
    for (int u = 0; u < NB; ++u) {
        const bf16* QS = (const bf16*)((unsigned char*)lds + u * SZ); const bf16* KS = QS + 64 * 72; bf16* AT = (bf16*)(KS + 64 * 72);
        const int tt = w >> 1, ntt = (it[u].nv + 15) >> 4;
#pragma unroll
        for (int v = 0; v < 2; ++v) { const int st = 2 * (w & 1) + v;
            f32x4 acc = (f32x4){0.f, 0.f, 0.f, 0.f};
            if (st <= tt && tt < ntt) {
#pragma unroll
                for (int ks = 0; ks < 2; ++ks) { const bf16x8 af = *(const bf16x8*)(QS + (16 * tt + c) * 72 + 32 * ks + 8 * q); const bf16x8 bfr = *(const bf16x8*)(KS + (16 * st + c) * 72 + 32 * ks + 8 * q); acc = mfma16(af, bfr, acc); } }
#pragma unroll
            for (int r = 0; r < 4; ++r) { const int tq = 16 * tt + 4 * q + r, s = 16 * st + c; AT[tq * 72 + s] = (s <= tq) ? (bf16)f2bf(acc[r]) : (bf16)0; }
        }
    }
    __syncthreads();
    f32x4 oacc[NB][4];
#pragma unroll
    for (int u = 0; u < NB; ++u) {
        const bf16* QS = (const bf16*)((unsigned char*)lds + u * SZ); const bf16* AT = QS + 2 * 64 * 72; const bf16* VT = AT + 64 * 72; const bf16* ST = VT + 128 * 72;
        const int ntt = (it[u].nv + 15) >> 4, nks = (it[u].nv + 31) >> 5;
        bf16x8 vf[2], sf[2];
#pragma unroll
        for (int ks = 0; ks < 2; ++ks) { vf[ks] = *(const bf16x8*)(VT + (16 * w + c) * 72 + fsw(w, ks, q)); sf[ks] = *(const bf16x8*)(ST + (16 * w + c) * 72 + fsw(w, ks, q)); }
#pragma unroll
        for (int tt = 0; tt < 4; ++tt) { oacc[u][tt] = (f32x4){0.f, 0.f, 0.f, 0.f};
            if (tt < ntt) {
#pragma unroll
                for (int ks = 0; ks < 2; ++ks) if (ks < nks) oacc[u][tt] = mfma16(*(const bf16x8*)(AT + (16 * tt + c) * 72 + 32 * ks + 8 * q), vf[ks], oacc[u][tt]);
#pragma unroll
                for (int ks = 0; ks < 2; ++ks) oacc[u][tt] = mfma16(*(const bf16x8*)(QS + (16 * tt + c) * 72 + 32 * ks + 8 * q), sf[ks], oacc[u][tt]);
            } }
    }
    __syncthreads();
#pragma unroll
    for (int u = 0; u < NB; ++u) {
        bf16* O = (bf16*)((unsigned char*)lds + u * SZ);
#pragma unroll
        for (int tt = 0; tt < 4; ++tt)
#pragma unroll
            for (int r = 0; r < 4; ++r) O[(16 * tt + 4 * q + r) * 136 + 16 * w + c] = (bf16)f2bf(oacc[u][tt][r]);
    }
    __syncthreads();
#pragma unroll
    for (int u = 0; u < NB; ++u) {
        const bf16* O = (const bf16*)((unsigned char*)lds + u * SZ);
        float of[16], gf[16];
        unpack8(*(const u32x4*)(O + t * 136 + j8 * 16), of); unpack8(*(const u32x4*)(O + t * 136 + j8 * 16 + 8), of + 8);
        unpack8(rg[u][0], gf); unpack8(rg[u][1], gf + 8);
        float ss = 0.f;
#pragma unroll
        for (int i = 0; i < 16; ++i) ss += of[i] * of[i];
        ss += __shfl_xor(ss, 1); ss += __shfl_xor(ss, 2); ss += __shfl_xor(ss, 4);
        const float rs = rsqrtf(ss * (1.0f / 128.0f) + EPS);
        if (t < it[u].nv) {
            const float* nw = (const float*)((const unsigned char*)lds + K3_OFF) + 32 + j8 * 16;
            const f32x4 n0 = *(const f32x4*)nw, n1 = *(const f32x4*)(nw + 4), n2 = *(const f32x4*)(nw + 8), n3 = *(const f32x4*)(nw + 12);
            const float nf[16] = {n0[0], n0[1], n0[2], n0[3], n1[0], n1[1], n1[2], n1[3], n2[0], n2[1], n2[2], n2[3], n3[0], n3[1], n3[2], n3[3]};
            float ov[16];
#pragma unroll
            for (int i = 0; i < 16; ++i) ov[i] = of[i] * rs * nf[i] * siluf(gf[i]);
            bf16* MX = (bf16*)(a.ws + WS_MIX) + (size_t)(it[u].row0 + it[u].t0 + t) * DM + it[u].h * 128 + j8 * 16;
            *(u32x4*)MX = pack8(ov); *(u32x4*)(MX + 8) = pack8(ov + 8);
        }
    }
}

__device__ __forceinline__ void r3_ssd(const Args& a, int l, int item, float* lds) {
    const int tid = opaque_tid(), lane = tid & 63, w = tid >> 6, c = lane & 15, q = lane >> 4;
    ItemG it;
    if (item < PB * NCH) { it.g = 0; it.n = item % NCH; it.b = item / NCH; it.L = PL; it.row0 = it.b * PL; }
    else { it.g = 1; it.b = item - PB * NCH; it.n = 0; it.L = SL; it.row0 = PT + it.b * SL; }
    it.h = 0; it.t0 = it.n * 64; it.nv = min(64, it.L - it.t0);
    unsigned char* lb = (unsigned char*)lds;
    float* dtv4 = (float*)lb; float* cum4 = dtv4 + 256;
    bf16* CS = (bf16*)(lb + 4096); bf16* BSm = (bf16*)(lb + 21504);
    bf16* XT4 = (bf16*)(lb + 38912);
    bf16* MM4 = (bf16*)(lb + 75776);
    bf16* Y0 = (bf16*)(lb + 112640);
    const int ntt = (it.nv + 15) >> 4, nks = (it.nv + 31) >> 5;
    const bf16* P = (const bf16*)(a.ws + WS_PROJ) + (size_t)(it.row0 + it.t0) * NIN;
    const int ts = tid >> 3, j8 = tid & 7;
    u32x4 zr[8];
    for (int gr = 0; gr < 2; ++gr) {
        const int hh = w >> 1, hd = gr * 4 + hh;
        if (tid < 256) { const int h4 = tid >> 6, t = tid & 63;
            dtv4[tid] = (t < it.nv) ? softplusf(bf2f(P[(size_t)t * NIN + CDT + gr * 4 + h4]) + a.in[I_DTB][l * 8 + gr * 4 + h4]) : 0.f; }
        bf16x8 hfr[2][4];
        if (it.g) { const float* Hsrc = a.in[I_SSSM] + ((size_t)(l * SB + it.b) * 8 + hd) * 8192;
#pragma unroll
            for (int u = 0; u < 2; ++u)
#pragma unroll
                for (int ks = 0; ks < 4; ++ks) { const float* hp = Hsrc + (16 * (2 * (w & 1) + u) + c) * 128 + 32 * ks + 8 * q; const f32x4 h0 = *(const f32x4*)hp, h1 = *(const f32x4*)(hp + 4);
                    const u32x4 pk = (u32x4){pk2(h0[0], h0[1]), pk2(h0[2], h0[3]), pk2(h1[0], h1[1]), pk2(h1[2], h1[3])}; hfr[u][ks] = __builtin_bit_cast(bf16x8, pk); }
        } else { const bf16* Hsrc = (const bf16*)(a.ws + WS_SS) + ((size_t)(it.b * NCH + it.n) * 8 + hd) * 8192;
#pragma unroll
            for (int u = 0; u < 2; ++u)
#pragma unroll
                for (int ks = 0; ks < 4; ++ks) hfr[u][ks] = *(const bf16x8*)(Hsrc + (16 * (2 * (w & 1) + u) + c) * 128 + 32 * ks + 8 * q);
        }
        {
            const bf16* XCr = (const bf16*)(a.ws + WS_XC) + (size_t)(it.row0 + it.t0 + ts) * 1024;
            u32x4 rc[2], rb[2], rx[4];
            const u32x4 z4 = (u32x4){0u, 0u, 0u, 0u};
#pragma unroll
            for (int hf = 0; hf < 2; ++hf) { rc[hf] = ts < it.nv ? *(const u32x4*)(XCr + 768 + gr * 128 + j8 * 16 + 8 * hf) : z4; rb[hf] = ts < it.nv ? *(const u32x4*)(XCr + 512 + gr * 128 + j8 * 16 + 8 * hf) : z4; }
#pragma unroll
            for (int h4 = 0; h4 < 4; ++h4) rx[h4] = ts < it.nv ? *(const u32x4*)(XCr + (gr * 4 + h4) * 64 + j8 * 8) : z4;
#pragma unroll
            for (int hf = 0; hf < 2; ++hf) { *(u32x4*)(CS + ts * 136 + j8 * 16 + 8 * hf) = rc[hf]; *(u32x4*)(BSm + ts * 136 + j8 * 16 + 8 * hf) = rb[hf]; }
#pragma unroll
            for (int h4 = 0; h4 < 4; ++h4) { const unsigned wv[4] = {rx[h4].x, rx[h4].y, rx[h4].z, rx[h4].w};
#pragma unroll
                for (int i = 0; i < 8; ++i) XT4[tsw(h4 * 64 + j8 * 8 + i, ts)] = (bf16)((i & 1) ? (wv[i >> 1] >> 16) : (wv[i >> 1] & 0xffffu)); }
        }
        __syncthreads();
        if (w < 4) { const float aa = ((const float*)(lb + K3_OFF))[gr * 4 + w]; cum4[w * 64 + lane] = wave_scan_incl(dtv4[w * 64 + lane] * aa, lane); }
        f32x4 cbacc[2]; const int ttc = w >> 1;
#pragma unroll
        for (int u = 0; u < 2; ++u) { const int st = 2 * (w & 1) + u; cbacc[u] = (f32x4){0.f, 0.f, 0.f, 0.f};
            if (st <= ttc && ttc < ntt) {
#pragma unroll
                for (int ks = 0; ks < 4; ++ks) cbacc[u] = mfma16(*(const bf16x8*)(CS + (16 * ttc + c) * 136 + 32 * ks + 8 * q), *(const bf16x8*)(BSm + (16 * st + c) * 136 + 32 * ks + 8 * q), cbacc[u]); } }
        __syncthreads();
#pragma unroll
        for (int h4 = 0; h4 < 4; ++h4)
#pragma unroll
            for (int u = 0; u < 2; ++u) { const int st = 2 * (w & 1) + u;
#pragma unroll
                for (int r = 0; r < 4; ++r) { const int t = 16 * ttc + 4 * q + r, s = 16 * st + c;
                    const float m = (s <= t) ? cbacc[u][r] * __expf(cum4[h4 * 64 + t] - cum4[h4 * 64 + s]) * dtv4[h4 * 64 + s] : 0.f;
                    MM4[h4 * 4608 + t * 72 + s] = (bf16)f2bf(m); } }
        __syncthreads();
        if (gr == 1) {
#pragma unroll
            for (int i = 0; i < 8; ++i) zr[i] = (ts < it.nv) ? *(const u32x4*)(P + (size_t)ts * NIN + CZ + (j8 + 8 * i) * 8) : (u32x4){0u, 0u, 0u, 0u}; }
        f32x4 yv[2][4];
        {
            const float dsk = ((const float*)(lb + K3_OFF))[8 + hd];
#pragma unroll
            for (int u = 0; u < 2; ++u) { const int pt = 2 * (w & 1) + u;
#pragma unroll
                for (int tt = 0; tt < 4; ++tt) { yv[u][tt] = (f32x4){0.f, 0.f, 0.f, 0.f};
                    if (tt < ntt) {
                        f32x4 ia = (f32x4){0.f, 0.f, 0.f, 0.f}, ie = ia;
#pragma unroll
                        for (int ks = 0; ks < 2; ++ks) if (ks < nks) ia = mfma16(*(const bf16x8*)(MM4 + hh * 4608 + (16 * tt + c) * 72 + 32 * ks + 8 * q), *(const bf16x8*)(XT4 + (hh * 64 + 16 * pt + c) * 72 + fsw(4 * hh + pt, ks, q)), ia);
#pragma unroll
                        for (int ks = 0; ks < 4; ++ks) ie = mfma16(*(const bf16x8*)(CS + (16 * tt + c) * 136 + 32 * ks + 8 * q), hfr[u][ks], ie);
#pragma unroll
                        for (int r = 0; r < 4; ++r) { const int t = 16 * tt + 4 * q + r, p = 16 * pt + c;
                            yv[u][tt][r] = ia[r] + __expf(cum4[hh * 64 + t]) * ie[r] + dsk * bf2f(XT4[tsw(hh * 64 + p, t)]); }
                    } } }
        }
        __syncthreads();
        {
            bf16* Yg = gr ? MM4 : Y0;
#pragma unroll
            for (int u = 0; u < 2; ++u)
#pragma unroll
                for (int tt = 0; tt < 4; ++tt)
#pragma unroll
                    for (int r = 0; r < 4; ++r) { const int t = 16 * tt + 4 * q + r, p = 16 * (2 * (w & 1) + u) + c;
                        if (t < it.nv) Yg[t * 264 + hh * 64 + p] = (bf16)f2bf(yv[u][tt][r]); }
        }
    }
    __syncthreads();
    {
        float yg[64]; float ss = 0.f;
        const bool ok = ts < it.nv;
#pragma unroll
        for (int i = 0; i < 8; ++i) { const int cc = (j8 + 8 * i) * 8;
            float y8[8], z8[8];
            if (ok) { unpack8(*(const u32x4*)(((cc >> 8) ? MM4 : Y0) + ts * 264 + (cc & 255)), y8); unpack8(zr[i], z8); }
            else {
#pragma unroll
                for (int j = 0; j < 8; ++j) { y8[j] = 0.f; z8[j] = 0.f; } }
#pragma unroll
            for (int j = 0; j < 8; ++j) { const float v = y8[j] * siluf(z8[j]); yg[8 * i + j] = v; ss += v * v; } }
        ss += __shfl_xor(ss, 1); ss += __shfl_xor(ss, 2); ss += __shfl_xor(ss, 4);
        const float rs = rsqrtf(ss * (1.0f / 512.0f) + EPS);
        if (ok) {
            bf16* MX = (bf16*)(a.ws + WS_MIX) + (size_t)(it.row0 + it.t0 + ts) * DM + 512;
#pragma unroll
            for (int i = 0; i < 8; ++i) { const int cc = (j8 + 8 * i) * 8;
                const float* nw = (const float*)(lb + K3_OFF) + 160 + cc; const f32x4 n0 = *(const f32x4*)nw, n1 = *(const f32x4*)(nw + 4);
                float f[8];
                f[0] = yg[8 * i] * rs * n0[0]; f[1] = yg[8 * i + 1] * rs * n0[1]; f[2] = yg[8 * i + 2] * rs * n0[2]; f[3] = yg[8 * i + 3] * rs * n0[3];
                f[4] = yg[8 * i + 4] * rs * n1[0]; f[5] = yg[8 * i + 5] * rs * n1[1]; f[6] = yg[8 * i + 6] * rs * n1[2]; f[7] = yg[8 * i + 7] * rs * n1[3];
                *(u32x4*)(MX + cc) = pack8(f); }
        }
    }
}

constexpr int R3_NB = 1;
__device__ __forceinline__ void r3_stage(const Args& a, int l, float* lds) {
    __syncthreads();
    float* k3 = (float*)((unsigned char*)lds + K3_OFF); const int tid = opaque_tid();
    if (tid < 8) { k3[tid] = -__expf(a.in[I_ALOG][l * 8 + tid]); k3[8 + tid] = a.in[I_DSKIP][l * 8 + tid]; }
    if (tid < 128) k3[32 + tid] = a.in[I_GLANW][l * 128 + tid];
    k3[160 + tid] = a.in[I_SSDNW][l * 512 + tid];
}
__device__ __forceinline__ void phase_r3(const Args& a, int l, float* lds, int rep) {
    constexpr int NS3 = PB * NCH + SB;
    static_assert(NGLA_P % R3_NB == 0 && NGLA % R3_NB == 0, "batches");
    unsigned* ctr = (unsigned*)(a.ws + WS_CTL) + CW_Q + ((l * 8 + 3) * 4 + rep) * 64;
    volatile unsigned* slot = (volatile unsigned*)((unsigned char*)lds + MISC_OFF) + 16;
    if (a.ph_hi - a.ph_lo == 1) { r3_stage(a, l, lds); __syncthreads(); }
    for (int u = blockIdx.x; u < NS3 + NGLA / R3_NB; ) {
        unsigned nxt = 0u;
        if (threadIdx.x == 0) nxt = gridDim.x + __hip_atomic_fetch_add(ctr, 1u, __ATOMIC_RELAXED, __HIP_MEMORY_SCOPE_AGENT);
        if (u < NS3) r3_ssd(a, l, u, lds); else r3_gla_b<R3_NB>(a, l, (u - NS3) * R3_NB, lds);
        if (threadIdx.x == 0) *slot = nxt;
        RAW_HANDOFF_BARRIER();
        u = (int)*slot;
    }
}

constexpr int UT_NT = 1096, UT_NE = 1024, UT_CAP = 20;
constexpr int UT_LCAP = UT_CAP * 512;
__device__ __forceinline__ unsigned ordkey(float s) { const unsigned u = __float_as_uint(s); return (u & 0x80000000u) ? ~u : (u | 0x80000000u); }
__device__ __forceinline__ float keyval(unsigned k) { return __uint_as_float((k & 0x80000000u) ? (k & 0x7fffffffu) : ~k); }
#define CE_DESC(a, b) { const unsigned _hi = max(a, b), _lo = min(a, b); a = _hi; b = _lo; }
__device__ __forceinline__ void sort16_desc(unsigned (&v)[16]) {
#pragma unroll
    for (int k = 2; k <= 16; k <<= 1)
#pragma unroll
        for (int j = k >> 1; j > 0; j >>= 1)
#pragma unroll
            for (int i = 0; i < 16; ++i) { const int l = i ^ j; if (l > i) { if ((i & k) == 0) CE_DESC(v[i], v[l]) else CE_DESC(v[l], v[i]) } }
}
__device__ __forceinline__ void merge16_desc(unsigned (&L)[16], const unsigned (&G)[16]) {
#pragma unroll
    for (int i = 0; i < 16; ++i) L[i] = max(L[i], G[15 - i]);
#pragma unroll
    for (int j = 8; j > 0; j >>= 1)
#pragma unroll
        for (int i = 0; i < 16; ++i) { const int l = i ^ j; if (l > i) CE_DESC(L[i], L[l]) }
}
__device__ __forceinline__ void xmerge16(unsigned (&L)[16], int mask) {
    unsigned G[16];
#pragma unroll
    for (int i = 0; i < 16; ++i) {
        if (mask == 16) { const auto r = __builtin_amdgcn_permlane16_swap(L[i], L[i], false, false); L[i] = r[0]; G[i] = r[1]; }
        else { const auto r = __builtin_amdgcn_permlane32_swap(L[i], L[i], false, false); L[i] = r[0]; G[i] = r[1]; } }
    merge16_desc(L, G);
}

__device__ __forceinline__ void xquant_tokens(const Args& a, int gw, int NGW) {
    const int lane = opaque_tid() & 63;
    {
        const bf16* HB = (const bf16*)(a.ws + WS_HB); const float* SSQ2 = (const float*)(a.ws + WS_SSQ2);
        for (int g4 = gw; g4 < T / 4; g4 += NGW) {
            u32x4 xq[4];
#pragma unroll
            for (int z = 0; z < 4; ++z) { const int t = 4 * g4 + z;
                float xf[16];
                unpack8(*(const u32x4*)(HB + (size_t)t * DM + lane * 16), xf); unpack8(*(const u32x4*)(HB + (size_t)t * DM + lane * 16 + 8), xf + 8);
                float am = 0.f;
#pragma unroll
                for (int i = 0; i < 16; ++i) am = fmaxf(am, fabsf(xf[i]));
#pragma unroll
                for (int o = 1; o < 64; o <<= 1) am = fmaxf(am, __shfl_xor(am, o));
                const float sx = am > 0.f ? am * (1.0f / 127.0f) : 1.0f, xinv = 1.0f / sx;
                unsigned wv[4];
#pragma unroll
                for (int j = 0; j < 4; ++j) { const int q0 = (int)rintf(xf[4 * j] * xinv), q1 = (int)rintf(xf[4 * j + 1] * xinv), q2 = (int)rintf(xf[4 * j + 2] * xinv), q3 = (int)rintf(xf[4 * j + 3] * xinv);
                    wv[j] = (unsigned)(q0 & 255) | ((unsigned)(q1 & 255) << 8) | ((unsigned)(q2 & 255) << 16) | ((unsigned)(q3 & 255) << 24); }
                xq[z] = (u32x4){wv[0], wv[1], wv[2], wv[3]};
                if (lane == 0) { float s2 = 0.f;
#pragma unroll
                    for (int i = 0; i < 16; ++i) s2 += SSQ2[(size_t)t * 16 + i];
                    ((float*)(a.ws + WS_HS))[t] = rsqrtf(s2 * (1.0f / 1024.0f) + EPS) * sx; }
            }
            u32x4* dst = (u32x4*)(a.ws + WS_X8 + ((size_t)lane * T + 4 * g4) * 16);
            dst[0] = xq[0]; dst[1] = xq[1]; dst[2] = xq[2]; dst[3] = xq[3];
        }
    }
}

__device__ __forceinline__ void route_stage(const Args& a, int l, float* lds) {
    __syncthreads();
    bf16* KB = (bf16*)lds; const int tid = opaque_tid();
    for (int i = tid; i < 2 * 128 * 8; i += NTHR) {
        const int hf = i >> 10, j = (i >> 3) & 127, g8 = i & 7;
        const float* src = a.in[hf ? I_K2 : I_K1] + (size_t)l * 8192 + j * 64 + g8 * 8;
        const f32x4 x0 = *(const f32x4*)src, x1 = *(const f32x4*)(src + 4);
        *(u32x4*)(KB + (hf * 128 + j) * 72 + g8 * 8) = (u32x4){pk2(x0[0], x0[1]), pk2(x0[2], x0[3]), pk2(x1[0], x1[1]), pk2(x1[2], x1[3])};
    }
}
__device__ __forceinline__ void phase_route(const Args& a, int l, float* lds) {
    const int tid = opaque_tid(), lane = tid & 63, wave = tid >> 6, c = lane & 15, q = lane >> 4;
    const bf16* KB = (const bf16*)lds;
    if (a.ph_hi - a.ph_lo == 1) { route_stage(a, l, lds); __syncthreads(); }
    const bf16* Q = (const bf16*)(a.ws + WS_Q);
    int* RE = (int*)(a.ws + WS_RE); float* RG = (float*)(a.ws + WS_RG);
    constexpr int NTASK = T * 8 / 16;
    unsigned* rel = (unsigned*)((unsigned char*)lds + 36864);
    unsigned* cnt = rel + 70 * 128; unsigned* bbase = cnt + 16; unsigned* loc = cnt + 32;
    constexpr int BCAP = 1024;
    unsigned* PL = (unsigned*)(a.ws + WS_PL); unsigned* GC = (unsigned*)(a.ws + WS_CTL) + CW_GC + l * 256;
    for (int job = blockIdx.x; job < 256; job += gridDim.x) {
    const int tb = job >> 4, part = job & 15, tl_lo = 2 * ((part * (UT_NT / 2)) >> 4), tl_hi = 2 * (((part + 1) * (UT_NT / 2)) >> 4), ntok = tl_hi - tl_lo;
    const int task_lo = (tb * UT_NT + tl_lo) >> 1, task_hi = task_lo + (ntok >> 1);
    if (tid < 16) cnt[tid] = 0u;
    const int task0 = task_lo + wave, tstride = NWAVES;
    u32x4 qn[4];
    {   const int p0 = min(task0, NTASK - 1) * 16 + c; const bf16* qp = Q + (size_t)(p0 >> 3) * DM + (p0 & 7) * 128 + 8 * q;
        qn[0] = *(const u32x4*)qp; qn[1] = *(const u32x4*)(qp + 32); qn[2] = *(const u32x4*)(qp + 64); qn[3] = *(const u32x4*)(qp + 96); }
    for (int task = task0; task < task_hi; task += tstride) {
        const int p = task * 16 + c, t = p >> 3, h = p & 7;
        const u32x4 qc[4] = {qn[0], qn[1], qn[2], qn[3]};
        {   const int pn = min(task + tstride, NTASK - 1) * 16 + c; const bf16* qp = Q + (size_t)(pn >> 3) * DM + (pn & 7) * 128 + 8 * q;
            qn[0] = *(const u32x4*)qp; qn[1] = *(const u32x4*)(qp + 32); qn[2] = *(const u32x4*)(qp + 64); qn[3] = *(const u32x4*)(qp + 96); }
        unsigned l1[16], l2[16];
#pragma unroll
        for (int half = 0; half < 2; ++half) {
            const bf16x8 b0 = __builtin_bit_cast(bf16x8, qc[2 * half]), b1 = __builtin_bit_cast(bf16x8, qc[2 * half + 1]);
            unsigned g0[16], g1[16];
#pragma unroll
            for (int n = 0; n < 8; ++n) {
                f32x4 acc = (f32x4){0.f, 0.f, 0.f, 0.f};
                const bf16* kp = KB + (half * 128 + 16 * n + c) * 72 + 8 * q;
                acc = mfma16(*(const bf16x8*)kp, b0, acc);
                acc = mfma16(*(const bf16x8*)(kp + 32), b1, acc);
#pragma unroll
                for (int r = 0; r < 4; ++r) { const unsigned key = (ordkey(acc[r]) & ~0x7Fu) | (unsigned)(16 * n + 4 * q + r);
                    if (n < 4) g0[4 * n + r] = key; else g1[4 * (n - 4) + r] = key; }
                if (n & 1) __builtin_amdgcn_sched_barrier(0);
            }
            sort16_desc(g0); __builtin_amdgcn_sched_barrier(0); sort16_desc(g1); __builtin_amdgcn_sched_barrier(0); merge16_desc(g0, g1); __builtin_amdgcn_sched_barrier(0);
            xmerge16(g0, 16); __builtin_amdgcn_sched_barrier(0); xmerge16(g0, 32); __builtin_amdgcn_sched_barrier(0);
#pragma unroll
            for (int i = 0; i < 16; ++i) { if (half == 0) l1[i] = g0[i]; else l2[i] = g0[i]; }
        }
        unsigned cA[16], cB[16];
        {
            const unsigned k10 = q == 0 ? l1[0] : (q == 1 ? l1[1] : (q == 2 ? l1[2] : l1[3]));
            const float v10 = keyval(k10 & ~0x7Fu);
#pragma unroll
            for (int j = 0; j < 16; ++j) { const float sum = v10 + keyval(l2[j] & ~0x7Fu);
                cA[j] = ((q + 1) * (j + 1) <= 16) ? ((ordkey(sum) & ~0xFFu) | (unsigned)(q * 16 + j)) : 0u; }
#pragma unroll
            for (int j = 0; j < 16; ++j) cB[j] = 0u;
#pragma unroll
            for (int ii = 1; ii < 4; ++ii) {
                const unsigned k1 = q == 0 ? l1[4 * ii] : (q == 1 ? l1[4 * ii + 1] : (q == 2 ? l1[4 * ii + 2] : l1[4 * ii + 3]));
                const float v1 = keyval(k1 & ~0x7Fu); const int i = 4 * ii + q;
#pragma unroll
                for (int j = 0; j < 3; ++j) if ((4 * ii + 1) * (j + 1) <= 16) {
                    const float sum = v1 + keyval(l2[j] & ~0x7Fu);
                    cB[(ii == 1 ? 0 : (ii == 2 ? 3 : 4)) + j] = ((i + 1) * (j + 1) <= 16) ? ((ordkey(sum) & ~0xFFu) | (unsigned)(i * 16 + j)) : 0u; }
            }
        }
        __builtin_amdgcn_sched_barrier(0);
        sort16_desc(cA); __builtin_amdgcn_sched_barrier(0); sort16_desc(cB); __builtin_amdgcn_sched_barrier(0); merge16_desc(cA, cB); __builtin_amdgcn_sched_barrier(0);
        xmerge16(cA, 16); __builtin_amdgcn_sched_barrier(0); xmerge16(cA, 32); __builtin_amdgcn_sched_barrier(0);
        float den = 0.f; const float mx = keyval(cA[0] & ~0xFFu);
#pragma unroll
        for (int k = 0; k < 16; ++k) den += __expf(keyval(cA[k] & ~0xFFu) - mx);
        const float inv = 1.0f / den;
#pragma unroll
        for (int kk = 0; kk < 4; ++kk) {
            const unsigned key = q == 0 ? cA[4 * kk] : (q == 1 ? cA[4 * kk + 1] : (q == 2 ? cA[4 * kk + 2] : cA[4 * kk + 3]));
            const unsigned ci = key & 0xFFu, ci1 = ci >> 4, ci2 = ci & 15u;
            unsigned i1 = 0u, i2 = 0u;
#pragma unroll
            for (int i = 0; i < 16; ++i) { i1 = (ci1 == (unsigned)i) ? (l1[i] & 0x7Fu) : i1; i2 = (ci2 == (unsigned)i) ? (l2[i] & 0x7Fu) : i2; }
            const size_t o = (size_t)t * 128 + h * 16 + 4 * kk + q;
            RE[o] = (int)(i1 * 128u + i2); RG[o] = __expf(keyval(key & ~0xFFu) - mx) * inv;
            rel[(t - (tb * UT_NT + tl_lo)) * 128 + h * 16 + 4 * kk + q] = i1 * 128u + i2;
        }
    }
    __syncthreads();
    for (int i = tid; i < ntok * 128; i += NTHR) { const int e = (int)rel[i], i1 = e >> 7, i2 = e & 127, eb = (i1 + i2) & 15;
        const unsigned pos = atomicAdd(&cnt[eb], 1u);
        if (pos < (unsigned)BCAP) loc[eb * BCAP + pos] = ((unsigned)(tl_lo * 128 + i) << 10) | (unsigned)((i1 << 3) | (i2 >> 4)); }
    __syncthreads();
    if (tid < 16) { const unsigned n = min(cnt[tid], (unsigned)BCAP); cnt[tid] = n; bbase[tid] = __hip_atomic_fetch_add(GC + tb * 16 + tid, n, __ATOMIC_RELAXED, __HIP_MEMORY_SCOPE_AGENT); }
    __syncthreads();
#pragma unroll 1
    for (int eb = 0; eb < 16; ++eb) { const unsigned n = cnt[eb], b0 = bbase[eb];
        for (unsigned i = tid; i < n; i += NTHR) if (b0 + i < (unsigned)UT_LCAP) PL[(size_t)(tb * 16 + eb) * UT_LCAP + b0 + i] = loc[eb * BCAP + i]; }
    __syncthreads();
    }
}

__device__ __forceinline__ float gelu_tanh(float x) {
    const float y = 0.7978845608028654f * (x + 0.044715f * x * x * x);
    const float th = 1.0f - 2.0f / (__expf(2.0f * y) + 1.0f);
    return 0.5f * x * (1.0f + th);
}

constexpr int UT_XB = 18432, UT_UB = UT_NE * 16, UT_STG = UT_XB + UT_UB;
static_assert(UT_XB >= UT_NT * 16 && UT_XB % 1024 == 0 && UT_UB % 1024 == 0, "LDS-DMA pieces of 1 KiB");
__device__ __forceinline__ void ut_glds(PG8_LAS unsigned char* stage, const unsigned char* xg, const unsigned char* ug, int ch, int wave, int lane) {
    const unsigned char* xn = xg + (size_t)ch * T * 16; const unsigned char* un = ug + (size_t)ch * 16384 * 16;
#pragma unroll
    for (int i = 0; i < 5; ++i) {
        const int p = i < 4 ? wave + 8 * i : (wave < 2 ? 32 + wave : wave + 24);
        const unsigned char* src = p < 18 ? xn + p * 1024 : un + (p - 18) * 1024;
        __builtin_amdgcn_global_load_lds((const unsigned*)(src + lane * 16), (PG8_LAS unsigned*)(stage + p * 1024), 16, 0, 0);
    }
}
#define UT_RAW_BARRIER() do { asm volatile("s_waitcnt lgkmcnt(0)" ::: "memory"); __builtin_amdgcn_s_barrier(); asm volatile("" ::: "memory"); } while (0)
template <int J0, int G>
__device__ __forceinline__ void ut_group(const unsigned (&po)[UT_CAP], int (&acc)[UT_CAP], const unsigned char* buf) {
    u32x4 xa[G], ua[G];
#pragma unroll
    for (int j = 0; j < G; ++j) { xa[j] = *(const u32x4*)(buf + (po[J0 + j] & 0xFFFFu)); ua[j] = *(const u32x4*)(buf + (po[J0 + j] >> 16)); }
#pragma unroll
    for (int j = 0; j < G; ++j) {
        int s = __builtin_amdgcn_sdot4((int)ua[j].x, (int)xa[j].x, acc[J0 + j], false); s = __builtin_amdgcn_sdot4((int)ua[j].y, (int)xa[j].y, s, false);
        s = __builtin_amdgcn_sdot4((int)ua[j].z, (int)xa[j].z, s, false); acc[J0 + j] = __builtin_amdgcn_sdot4((int)ua[j].w, (int)xa[j].w, s, false);
        asm volatile("" : "+v"(acc[J0 + j])); }
    asm volatile("" ::: "memory");
}
__device__ __forceinline__ void ut_compute(const unsigned (&po)[UT_CAP], int (&acc)[UT_CAP], const unsigned char* buf, int nslots) {
    static_assert(UT_CAP == 20, "slot groups: 4 x 4 unconditional, then 2 + 2 skipped (tile-uniformly) when the tile's list is short enough (slot j holds list entries 512 j ..)");
    ut_group<0, 4>(po, acc, buf); ut_group<4, 4>(po, acc, buf); ut_group<8, 4>(po, acc, buf); ut_group<12, 4>(po, acc, buf);
    if (nslots > 16) ut_group<16, 2>(po, acc, buf);
    if (nslots > 18) ut_group<18, 2>(po, acc, buf);
}
__device__ __forceinline__ void phase_utile(const Args& a, int l, float* lds, PG8_LAS unsigned char* ldsl) {
    static_assert(T == 16 * UT_NT, "16 token blocks");
    const int tid = opaque_tid();
    unsigned char* lb = (unsigned char*)lds;
    static_assert(4 * UT_STG <= MISC_OFF, "LDS map");
    const float* HS = (const float*)(a.ws + WS_HS); const float* US = (const float*)(a.ws + WS_US) + l * 16384;
    const unsigned* PL = (const unsigned*)(a.ws + WS_PL); const unsigned* GC = (const unsigned*)(a.ws + WS_CTL) + CW_GC + l * 256;
    for (int tile = blockIdx.x; tile < 256; tile += gridDim.x) {
        const int tb = tile >> 4, eb = tile & 15, tok0 = tb * UT_NT;
        const unsigned char* xg = a.ws + WS_X8 + (size_t)tok0 * 16;
        const unsigned char* ug = a.ws + WS_UB + ((size_t)(l * 64) * 16384 + (size_t)eb * UT_NE) * 16;
        const int wave = __builtin_amdgcn_readfirstlane(tid >> 6), lane = tid & 63;
        ut_glds(ldsl, xg, ug, 0, wave, lane); ut_glds(ldsl + UT_STG, xg, ug, 1, wave, lane); ut_glds(ldsl + 2 * UT_STG, xg, ug, 2, wave, lane);
        asm volatile("" ::: "memory");
        const int n = min((int)GC[tile], UT_LCAP);
        const int nslots = __builtin_amdgcn_readfirstlane((n + NTHR - 1) / NTHR);
        unsigned pr[UT_CAP], po[UT_CAP]; int acc[UT_CAP];
#pragma unroll
        for (int j = 0; j < UT_CAP; ++j) { const int idx = tid + NTHR * j; pr[j] = idx < n ? PL[(size_t)tile * UT_LCAP + idx] : 0xFFFFFFFFu; acc[j] = 0;
            po[j] = pr[j] == 0xFFFFFFFFu ? ((unsigned)UT_XB << 16) : (((pr[j] >> 17) * 16u) | ((UT_XB + (pr[j] & 1023u) * 16u) << 16)); }
        static_assert(UT_STG < 65536, "packed LDS offsets");
        static_assert(UT_NT <= 3 * NTHR && UT_NE == 2 * NTHR, "scale table registers");
        const float hs0 = HS[tok0 + tid], hs1 = HS[tok0 + tid + NTHR], hs2 = (tid + 2 * NTHR < UT_NT) ? HS[tok0 + tid + 2 * NTHR] : 0.f;
        float us0, us1;
        { const int i0 = tid, i1a = i0 >> 3; us0 = US[i1a * 128 + (((i0 & 7) << 4) | ((eb - i1a) & 15))];
          const int i2 = tid + NTHR, i1b = i2 >> 3; us1 = US[i1b * 128 + (((i2 & 7) << 4) | ((eb - i1b) & 15))]; }
        asm volatile("" ::: "memory");
#pragma unroll 1
        for (int ch = 0; ch < 61; ++ch) {
            asm volatile("s_waitcnt vmcnt(10)" ::: "memory");
            UT_RAW_BARRIER();
            ut_glds(ldsl + ((ch + 3) & 3) * UT_STG, xg, ug, ch + 3, wave, lane);
            ut_compute(po, acc, lb + (ch & 3) * UT_STG, nslots);
        }
        asm volatile("s_waitcnt vmcnt(10)" ::: "memory"); UT_RAW_BARRIER(); ut_compute(po, acc, lb + (61 & 3) * UT_STG, nslots);
        asm volatile("s_waitcnt vmcnt(5)" ::: "memory");  UT_RAW_BARRIER(); ut_compute(po, acc, lb + (62 & 3) * UT_STG, nslots);
        asm volatile("s_waitcnt vmcnt(0)" ::: "memory");  UT_RAW_BARRIER(); ut_compute(po, acc, lb + (63 & 3) * UT_STG, nslots);
        __syncthreads();
        {
            float* hsl = (float*)lb; float* usl = hsl + UT_NT;
            hsl[tid] = hs0; hsl[tid + NTHR] = hs1; if (tid + 2 * NTHR < UT_NT) hsl[tid + 2 * NTHR] = hs2;
            usl[tid] = us0; usl[tid + NTHR] = us1;
            __syncthreads();
#pragma unroll
            for (int j = 0; j < UT_CAP; ++j) if (pr[j] != 0xFFFFFFFFu) {
                const unsigned i = pr[j] >> 10;
                ((float*)(a.ws + WS_WP))[(size_t)tok0 * 128 + i] = (float)acc[j] * (hsl[i >> 7] * usl[pr[j] & 1023u]);
            }
        }
        __syncthreads();
    }
}

__device__ __forceinline__ float ub0(unsigned v) { return (float)(v & 255u); }
__device__ __forceinline__ float ub1(unsigned v) { return (float)((v >> 8) & 255u); }
__device__ __forceinline__ float ub2(unsigned v) { return (float)((v >> 16) & 255u); }
__device__ __forceinline__ float ub3(unsigned v) { return (float)(v >> 24); }
__device__ __forceinline__ void phase_experts(const Args& a, int l) {
    const int tid = opaque_tid(), lane = tid & 63, wave = tid >> 6;
    const unsigned char* VB = a.ws + WS_VB + (size_t)l * 16384 * DM;
    float* H = (float*)(a.ws + WS_H); bf16* HB = (bf16*)(a.ws + WS_HB);
    const int* RE = (const int*)(a.ws + WS_RE); const float* RG = (const float*)(a.ws + WS_RG);
    float* SSQ1 = (float*)(a.ws + WS_SSQ1);
    const float* WP = (const float*)(a.ws + WS_WP); const float* VS = (const float*)(a.ws + WS_VS) + l * 16384;
    const int tstep = gridDim.x * NWAVES, tfirst = blockIdx.x * NWAVES + wave;
    int e1a = 0, e1b = 0, e2a = 0, e2b = 0; float g1a = 0.f, g1b = 0.f, h1a = 0.f, h1b = 0.f, g2a = 0.f, g2b = 0.f, h2a = 0.f, h2b = 0.f;
    int ea = 0, eb2 = 0; float wa = 0.f, wb = 0.f;
    if (tfirst < T) { const size_t o = (size_t)tfirst * 128 + lane; ea = RE[o]; eb2 = RE[o + 64];
        wa = RG[o] * gelu_tanh(WP[o]) * VS[ea]; wb = RG[o + 64] * gelu_tanh(WP[o + 64]) * VS[eb2]; }
    if (tfirst + tstep < T) { const size_t o = (size_t)(tfirst + tstep) * 128 + lane; e1a = RE[o]; e1b = RE[o + 64]; g1a = RG[o]; g1b = RG[o + 64]; h1a = WP[o]; h1b = WP[o + 64]; }
    for (int t = tfirst; t < T; t += tstep) {
        if (t + 2 * tstep < T) { const size_t o = (size_t)(t + 2 * tstep) * 128 + lane; e2a = RE[o]; e2b = RE[o + 64]; g2a = RG[o]; g2b = RG[o + 64]; h2a = WP[o]; h2b = WP[o + 64]; }
        const float vs1a = VS[e1a], vs1b = VS[e1b];
        float out[16]; float wsum = 0.f;
        for (int rep = 0; rep < a.rep[7]; ++rep) {
#pragma unroll
        for (int i = 0; i < 16; ++i) out[i] = 0.f;
        wsum = 0.f;
#pragma unroll
        for (int hb = 0; hb < 2; ++hb) {
        const int ev = hb ? eb2 : ea; const float wv = hb ? wb : wa;
        for (int k0 = 0; k0 < 64; k0 += 16) {
            int e[16]; float wp[16];
#pragma unroll
            for (int k = 0; k < 16; ++k) { e[k] = __builtin_amdgcn_readlane(ev, k0 + k); wp[k] = __builtin_bit_cast(float, __builtin_amdgcn_readlane(__builtin_bit_cast(int, wv), k0 + k)); }
            u32x4 vr[16];
#pragma unroll
            for (int k = 0; k < 16; ++k) vr[k] = *(const u32x4*)(VB + (size_t)e[k] * DM + lane * 16);
#pragma unroll
            for (int k = 0; k < 16; ++k) { const float w = wp[k]; wsum += w;
                const unsigned v0 = vr[k].x, v1 = vr[k].y, v2 = vr[k].z, v3 = vr[k].w;
                out[0] += w * ub0(v0); out[1] += w * ub1(v0); out[2] += w * ub2(v0); out[3] += w * ub3(v0);
                out[4] += w * ub0(v1); out[5] += w * ub1(v1); out[6] += w * ub2(v1); out[7] += w * ub3(v1);
                out[8] += w * ub0(v2); out[9] += w * ub1(v2); out[10] += w * ub2(v2); out[11] += w * ub3(v2);
                out[12] += w * ub0(v3); out[13] += w * ub1(v3); out[14] += w * ub2(v3); out[15] += w * ub3(v3); }
        }
        }
        }
        const float corr = 128.0f * wsum;
        float* hp = H + (size_t)t * DM + lane * 16;
        f32x4 h0 = *(const f32x4*)hp, h1 = *(const f32x4*)(hp + 4), h2 = *(const f32x4*)(hp + 8), h3 = *(const f32x4*)(hp + 12);
        h0 += (f32x4){out[0] - corr, out[1] - corr, out[2] - corr, out[3] - corr}; h1 += (f32x4){out[4] - corr, out[5] - corr, out[6] - corr, out[7] - corr};
        h2 += (f32x4){out[8] - corr, out[9] - corr, out[10] - corr, out[11] - corr}; h3 += (f32x4){out[12] - corr, out[13] - corr, out[14] - corr, out[15] - corr};
        float ss = (h0[0] * h0[0] + h0[1] * h0[1] + h0[2] * h0[2] + h0[3] * h0[3]) + (h1[0] * h1[0] + h1[1] * h1[1] + h1[2] * h1[2] + h1[3] * h1[3])
                 + (h2[0] * h2[0] + h2[1] * h2[1] + h2[2] * h2[2] + h2[3] * h2[3]) + (h3[0] * h3[0] + h3[1] * h3[1] + h3[2] * h3[2] + h3[3] * h3[3]);
        ss = wave_sum(ss);
        if (l < NLAY - 1) {
            *(f32x4*)hp = h0; *(f32x4*)(hp + 4) = h1; *(f32x4*)(hp + 8) = h2; *(f32x4*)(hp + 12) = h3;
            *(u32x4*)(HB + (size_t)t * DM + lane * 16) = (u32x4){pk2(h0[0], h0[1]), pk2(h0[2], h0[3]), pk2(h1[0], h1[1]), pk2(h1[2], h1[3])};
            *(u32x4*)(HB + (size_t)t * DM + lane * 16 + 8) = (u32x4){pk2(h2[0], h2[1]), pk2(h2[2], h2[3]), pk2(h3[0], h3[1]), pk2(h3[2], h3[3])};
            if (lane == 0) SSQ1[t] = ss;
        } else {
            const float rs = rsqrtf(ss * (1.0f / 1024.0f) + EPS);
            float* op = nullptr;
            if (t < PT) { const int b = t / PL, ts = t % PL; if (ts >= 16) op = a.out + O_YP + ((size_t)b * 2048 + (ts - 16)) * DM; }
            else op = a.out + O_YS + (size_t)(t - PT) * DM;
            if (op) { const float* fw = a.in[I_FNW] + lane * 16; op += lane * 16;
                const f32x4 w0 = *(const f32x4*)fw, w1 = *(const f32x4*)(fw + 4), w2 = *(const f32x4*)(fw + 8), w3 = *(const f32x4*)(fw + 12);
                *(f32x4*)op = h0 * rs * w0; *(f32x4*)(op + 4) = h1 * rs * w1; *(f32x4*)(op + 8) = h2 * rs * w2; *(f32x4*)(op + 12) = h3 * rs * w3; }
        }
        ea = e1a; eb2 = e1b; wa = g1a * gelu_tanh(h1a) * vs1a; wb = g1b * gelu_tanh(h1b) * vs1b;
        e1a = e2a; e1b = e2b; g1a = g2a; g1b = g2b; h1a = h2a; h1b = h2b;
    }
}

template <int PH>
__device__ __forceinline__ void run_phase(LAS unsigned char* lds, float* ldsf) {
#if defined(__HIP_DEVICE_COMPILE__)
    typedef const __attribute__((address_space(4))) Args* KArgsPtr;
    KArgsPtr ap = (KArgsPtr)__builtin_amdgcn_kernarg_segment_ptr();
    asm volatile("" : "+s"(ap));
    const Args args = *ap;
#else
    Args args{};
#endif
    unsigned char* ws = args.ws;
    if constexpr (PH == 0) { for (int r = 0; r < args.rep[8]; ++r) phase_prologue(args, lds); }
    else {
        constexpr int l = (PH - 1) / 9, sub = (PH - 1) % 9;
        if constexpr (sub == 0 || sub == 4 || sub == 5) {
            const bf16* A = (const bf16*)(ws + (sub == 4 ? WS_MIX : WS_HB));
            const bf16* Bt = sub == 0 ? (const bf16*)(ws + WS_WIN) + (size_t)l * NIN * DM : (const bf16*)(ws + (sub == 4 ? WS_WOUT : WS_WQ)) + (size_t)l * DM * DM;
            constexpr int N = sub == 0 ? NIN : DM;
            pg8::Gemm g{A, Bt, MP, N, DM}; pg8::StaticOrder S; S.init(MP, N, gridDim.x, blockIdx.x);
            pg8::EpiUni E;
            E.mode = sub == 4 ? 1 : 0; E.O = (bf16*)(ws + (sub == 0 ? WS_PROJ : (sub == 4 ? WS_HB : WS_Q))); E.ldc = N;
            E.ssq = (const float*)(ws + (sub == 0 ? WS_SSQ1 : WS_SSQ2)); E.nparts = sub == 0 ? 1 : 16; E.H = (float*)(ws + WS_H); E.ssqp = (float*)(ws + WS_SSQ2);
            const int nrep = sub == 4 ? 1 : args.rep[sub];
            for (int r = 0; r < nrep; ++r) pg8::gemm_phase<pg8::EpiUni, pg8::StaticOrder, true, true>(lds, g, S, E);
            {
                constexpr int nwg = (MP / 256) * (N / 256);
                const int G = gridDim.x, c = blockIdx.x, rounds = (nwg + G - 1) / G, nfull = nwg - (rounds - 1) * G;
                const int wave = opaque_tid() >> 6;
                int gw, NGW;
                if (nfull < G) { gw = (c - nfull) * NWAVES + wave; NGW = (G - nfull) * NWAVES; if (c < nfull) gw = -1; }
                else { gw = c * NWAVES + wave; NGW = G * NWAVES; }
                if (gw >= 0) {
                    if constexpr (sub == 0) quant_u_layer(args, l, gw, NGW);
                    else if constexpr (sub == 4) quant_v_layer(args, l, 0, 8192, gw, NGW);
                    else { quant_v_layer(args, l, 8192, 16384, gw, NGW); xquant_tokens(args, gw, NGW); }
                }
            }
            if (args.ph_hi - args.ph_lo > 1) { if constexpr (sub == 0) r1_stage(args, l, ldsf); else if constexpr (sub == 5) route_stage(args, l, ldsf); }
        } else if constexpr (sub == 1) { for (int r = 0; r < args.rep[1]; ++r) phase_r1(args, l, ldsf, r); }
        else if constexpr (sub == 2) { phase_r2(args, l); if (args.ph_hi - args.ph_lo > 1) r3_stage(args, l, ldsf); }
        else if constexpr (sub == 3) { for (int r = 0; r < args.rep[3]; ++r) phase_r3(args, l, ldsf, r); }
        else if constexpr (sub == 6) { for (int r = 0; r < args.rep[6]; ++r) phase_route(args, l, ldsf); }
        else if constexpr (sub == 7) { for (int r = 0; r < args.rep[9]; ++r) phase_utile(args, l, ldsf, lds); }
        else phase_experts(args, l);
    }
}

constexpr int NPHASE = 1 + 9 * NLAY;
__global__ void __launch_bounds__(NTHR, 2) fwd_kernel(Args kargs) {
    extern __shared__ __attribute__((aligned(16))) unsigned char lds_raw[];
    LAS unsigned char* lds = (LAS unsigned char*)lds_raw;
    float* ldsf = (float*)lds_raw;
    volatile LAS unsigned* MISC = (volatile LAS unsigned*)(lds + MISC_OFF);
    if (kargs.ph_hi - kargs.ph_lo > 1) {
        if (threadIdx.x < 32) MISC[threadIdx.x] = 0u;
        __syncthreads();
        const XcdBarrier b0 = xcd_barrier_post((unsigned*)(kargs.ws + WS_CTL) + CW_BAR, MISC + 8);
        if (threadIdx.x == 0) MISC[10] = b0.x;
        __syncthreads();
    }
    const int lo = kargs.ph_lo, hi = kargs.ph_hi;
#define RUN_PHASE(PH) if (lo <= (PH) && (PH) < hi) { run_phase<(PH)>(lds, ldsf); if ((PH) + 1 < hi) { for (int xb = 0; xb < kargs.rep[4]; ++xb) { XcdBarrier bar; bar.bar = (unsigned*)(kargs.ws + WS_CTL) + CW_BAR; bar.x = MISC[10]; bar.st = MISC + 8; xcd_barrier(bar); } } }
    RUN_PHASE(0)
    RUN_PHASE(1) RUN_PHASE(2) RUN_PHASE(3) RUN_PHASE(4) RUN_PHASE(5) RUN_PHASE(6) RUN_PHASE(7) RUN_PHASE(8)
    RUN_PHASE(9) RUN_PHASE(10) RUN_PHASE(11) RUN_PHASE(12) RUN_PHASE(13) RUN_PHASE(14) RUN_PHASE(15) RUN_PHASE(16)
    RUN_PHASE(17) RUN_PHASE(18) RUN_PHASE(19) RUN_PHASE(20) RUN_PHASE(21) RUN_PHASE(22) RUN_PHASE(23) RUN_PHASE(24)
    RUN_PHASE(25) RUN_PHASE(26) RUN_PHASE(27) RUN_PHASE(28) RUN_PHASE(29) RUN_PHASE(30) RUN_PHASE(31) RUN_PHASE(32)
    RUN_PHASE(33) RUN_PHASE(34) RUN_PHASE(35) RUN_PHASE(36) RUN_PHASE(37) RUN_PHASE(38) RUN_PHASE(39) RUN_PHASE(40)
#undef RUN_PHASE
}

extern "C" void kernel_launch(void* const* d_in, const int* in_sizes, int n_in, void* d_out, int out_size, void* d_ws, size_t ws_size, hipStream_t stream) {
    static int grid = 0;
    if (grid == 0) {
        if (n_in != 25 || ws_size < WS_END || out_size != 72974336) { fprintf(stderr, "kernel_launch: unexpected shapes (n_in %d, out %d, ws %zu, need %zu)\n", n_in, out_size, ws_size, (size_t)WS_END); grid = -1; return; }
        int dev = 0, cus = 0, per_cu = 0;
        if (hipGetDevice(&dev) != hipSuccess || hipDeviceGetAttribute(&cus, hipDeviceAttributeMultiprocessorCount, dev) != hipSuccess) { grid = -1; return; }
        if (hipFuncSetAttribute((const void*)fwd_kernel, hipFuncAttributeMaxDynamicSharedMemorySize, LDS_BYTES) != hipSuccess) { fprintf(stderr, "kernel_launch: hipFuncSetAttribute failed\n"); grid = -1; return; }
        if (hipOccupancyMaxActiveBlocksPerMultiprocessor(&per_cu, (const void*)fwd_kernel, NTHR, LDS_BYTES) != hipSuccess || per_cu < 1) { fprintf(stderr, "kernel_launch: occupancy query says %d\n", per_cu); per_cu = 1; }
        (void)hipGetLastError();
        grid = cus;
    }
    if (grid < 0) return;
    (void)hipMemsetAsync((char*)d_ws + WS_CTL, 0, CTL_BYTES, stream);
    Args a{};
    for (int i = 0; i < 25; ++i) a.in[i] = (const float*)d_in[i];
    a.out = (float*)d_out; a.ws = (unsigned char*)d_ws;
    { const int rp[10] = PROBE_REP; for (int i = 0; i < 10; ++i) a.rep[i] = rp[i]; }
#if MK_ONE_LAUNCH
    a.ph_lo = 0; a.ph_hi = NPHASE;
    void* kargs[] = {&a};
    hipError_t e = hipLaunchCooperativeKernel((const void*)fwd_kernel, dim3(grid), dim3(NTHR), kargs, LDS_BYTES, stream);
    if (e != hipSuccess) fprintf(stderr, "cooperative launch failed: %s (grid %d)\n", hipGetErrorString(e), grid);
#else
    for (int ph = 0; ph < NPHASE; ++ph) {
        a.ph_lo = ph; a.ph_hi = ph + 1;
        hipLaunchKernelGGL(fwd_kernel, dim3(grid), dim3(NTHR), LDS_BYTES, stream, a);
    }
#endif
}
```

```cpp
#include <hip/hip_runtime.h>
#include <cstdio>
#include <cstdint>

#ifndef MK_ONE_LAUNCH
#define MK_ONE_LAUNCH 1
#endif

__device__ __forceinline__ int opaque_tid() { int t = threadIdx.x; asm volatile("" : "+v"(t)); return t; }
__device__ __forceinline__ int opaque_bid() { int b = blockIdx.x; asm volatile("" : "+s"(b)); return b; }
namespace pg8 {
#define PG8_LAS __attribute__((address_space(3)))
typedef unsigned short bf16_t;
typedef short bf16x8 __attribute__((ext_vector_type(8)));
typedef float f32x4 __attribute__((ext_vector_type(4)));
typedef unsigned u32x4 __attribute__((ext_vector_type(4)));
typedef unsigned u32x2 __attribute__((ext_vector_type(2)));
constexpr int BM = 256, BK = 64, HALF = 128, HTB = HALF * BK * 2, STAGE_BYTES = 8 * HTB, NXCD = 8, WGM = 8;

__host__ __device__ __forceinline__ int lds_byte(int r, int c) { const int st = (r >> 4) * 2 + (c >> 5), rr = r & 15, cc = c & 31, ob = rr * 64 + cc * 2; return st * 1024 + (ob ^ (((ob >> 9) & 1) << 5)); }
__host__ __device__ __forceinline__ void stage_rc(int b, int& R, int& C) { const int st = b / 1024, sb = b % 1024, swz = sb ^ (((sb >> 9) & 1) << 5); R = (st >> 1) * 16 + swz / 64; C = (st & 1) * 32 + (swz % 64) / 2; }
__host__ __device__ __forceinline__ int perm32(int rho) { const int n = rho >> 4, i = rho & 15; return 8 * (i >> 2) + 4 * n + (i & 3); }

struct Unit { int pm, pn; };
struct Gemm { const bf16_t* A; const bf16_t* Bt; int M, N, K; };

struct StaticOrder {
    int nM, nN, nwg, G, c;
    __host__ __device__ void init(int M, int N, int G_, int c_) { nM = M / BM; nN = N / BM; nwg = nM * nN; G = G_; c = c_; }
    __host__ __device__ bool next(int i, Unit& u) const {
        const long L = (long)i * G + c; if (L >= nwg) return false;
        int wgid = (int)L; { const int q = nwg / NXCD, r = nwg % NXCD, xcd = wgid % NXCD, off = wgid / NXCD; wgid = (xcd < r ? xcd * (q + 1) : r * (q + 1) + (xcd - r) * q) + off; }
        const int nig = WGM * nN, gid = wgid / nig, fm = gid * WGM, gsz = (nM - fm) < WGM ? (nM - fm) : WGM;
        u.pm = fm + ((wgid % nig) % gsz); u.pn = (wgid % nig) / gsz; return true;
    }
    __device__ __forceinline__ void a_ready(const Unit&) const {}
    __device__ __forceinline__ void done(const Unit&) const {}
};

__device__ __forceinline__ unsigned cvt_pk_bf16(float lo, float hi) { unsigned r; asm volatile("v_cvt_pk_bf16_f32 %0, %1, %2" : "=v"(r) : "v"(lo), "v"(hi)); return r; }


struct EpiUni {
    static constexpr bool PERM = true, AFTER_DRAIN = false;
    int mode; bf16_t* O; int ldc; const float* ssq; int nparts; float* H; float* ssqp;
    __device__ __forceinline__ void operator()(const f32x4 (&acc)[2][2][4][2], const Unit& u, int wr, int wc, int fr, int fq) const {
        const int row0 = u.pm * BM + wr * 64 + fr; const int col0 = u.pn * BM + wc * 32 + 8 * fq;
        if (mode == 0) {
#pragma unroll
            for (int ai = 0; ai < 2; ++ai)
#pragma unroll
                for (int m = 0; m < 4; ++m) {
                    const int row = row0 + ai * HALF + m * 16;
                    float s = 0.f;
                    for (int i = 0; i < nparts; ++i) s += ssq[(size_t)row * nparts + i];
                    const float sc = rsqrtf(s * (1.0f / 1024.0f) + 1e-6f);
                    bf16_t* rowp = O + (size_t)row * ldc + col0;
#pragma unroll
                    for (int bj = 0; bj < 2; ++bj) { f32x4 v0 = acc[ai][bj][m][0] * sc, v1 = acc[ai][bj][m][1] * sc;
                        u32x4 w; w.x = cvt_pk_bf16(v0[0], v0[1]); w.y = cvt_pk_bf16(v0[2], v0[3]); w.z = cvt_pk_bf16(v1[0], v1[1]); w.w = cvt_pk_bf16(v1[2], v1[3]);
                        *(u32x4*)(rowp + bj * HALF) = w; } }
        } else {
#pragma unroll
            for (int ai = 0; ai < 2; ++ai)
#pragma unroll
                for (int m = 0; m < 4; ++m) {
                    const int row = row0 + ai * HALF + m * 16; float ss = 0.f;
#pragma unroll
                    for (int bj = 0; bj < 2; ++bj) {
                        const size_t off = (size_t)row * 1024 + col0 + bj * HALF;
                        f32x4 h0 = *(const f32x4*)(H + off), h1 = *(const f32x4*)(H + off + 4);
                        h0 = h0 + acc[ai][bj][m][0]; h1 = h1 + acc[ai][bj][m][1];
                        *(f32x4*)(H + off) = h0; *(f32x4*)(H + off + 4) = h1;
                        u32x4 w; w.x = cvt_pk_bf16(h0[0], h0[1]); w.y = cvt_pk_bf16(h0[2], h0[3]); w.z = cvt_pk_bf16(h1[0], h1[1]); w.w = cvt_pk_bf16(h1[2], h1[3]);
                        *(u32x4*)(O + off) = w;
                        ss += (h0[0] * h0[0] + h0[1] * h0[1]) + (h0[2] * h0[2] + h0[3] * h0[3]) + (h1[0] * h1[0] + h1[1] * h1[1]) + (h1[2] * h1[2] + h1[3] * h1[3]);
                    }
                    ss += __shfl_xor(ss, 16); ss += __shfl_xor(ss, 32);
                    if (fq == 0) ssqp[(size_t)row * 16 + u.pn * 4 + wc] = ss;
                }
        }
    }
};

template <class Epi, class Sched, bool ALIGN_EPI = false, bool SP2 = false>
__device__ __forceinline__ void gemm_phase(PG8_LAS unsigned char* lds, const Gemm g, const Sched& S, const Epi& E) {
    const int tid = opaque_tid(), wid = __builtin_amdgcn_readfirstlane(tid >> 6), lane = tid & 63, wr = wid >> 2, wc = wid & 3, fr = lane & 15, fq = lane >> 4;
    const int K = g.K, nt = K / BK;
    unsigned voffA[2], voffB[2];
#pragma unroll
    for (int i = 0; i < 2; ++i) { int R, C; stage_rc(tid * 16 + i * 8192, R, C); const int Rb = Epi::PERM ? ((R & ~31) + perm32(R & 31)) : R;
        voffA[i] = (unsigned)(R * K + C) * 2u; voffB[i] = (unsigned)(Rb * K + C) * 2u; }
    const size_t kstep = (size_t)(BK * 2);
    const size_t hstep = (size_t)HALF * K * 2;
    const size_t tstep = 2 * hstep;
    const unsigned ldsw = (unsigned)wid * 1024u;
    const int aoff = lds_byte(wr * 64 + fr, fq * 8), boff = lds_byte(wc * 32 + fr, fq * 8);
#define PG8_SA(b, h) (((b) * 2 + (h)) * HTB)
#define PG8_SB(b, h) ((4 + (b) * 2 + (h)) * HTB)
#define PG8_STAGE(bufoff, gbase, voff) do { _Pragma("unroll") for (int _i = 0; _i < 2; ++_i) \
        __builtin_amdgcn_global_load_lds((const unsigned*)((const char*)(gbase) + (voff)[_i]), (PG8_LAS unsigned*)(lds + (bufoff) + ldsw + _i * 8192), 16, 0, 0); } while (0)
#define PG8_LDA(dst, b, h) do { _Pragma("unroll") for (int m = 0; m < 4; ++m) _Pragma("unroll") for (int k = 0; k < 2; ++k) dst[m][k] = *(const PG8_LAS bf16x8*)(lds + PG8_SA(b, h) + aoff + m * 2048 + k * 1024); } while (0)
#define PG8_LDB(dst, b, h) do { _Pragma("unroll") for (int n = 0; n < 2; ++n) _Pragma("unroll") for (int k = 0; k < 2; ++k) dst[n][k] = *(const PG8_LAS bf16x8*)(lds + PG8_SB(b, h) + boff + n * 2048 + k * 1024); } while (0)
#define PG8_MMA(ai, bj, At, Bt) do { __builtin_amdgcn_s_setprio(1); _Pragma("unroll") for (int m = 0; m < 4; ++m) _Pragma("unroll") for (int n = 0; n < 2; ++n) _Pragma("unroll") for (int k = 0; k < 2; ++k) \
        acc[ai][bj][m][n] = __builtin_amdgcn_mfma_f32_16x16x32_bf16(Bt[n][k], At[m][k], acc[ai][bj][m][n], 0, 0, 0); __builtin_amdgcn_s_setprio(0); } while (0)
#define PG8_WAIT_V(n) asm volatile("s_waitcnt vmcnt(" #n ")" ::: "memory")
#define PG8_WAIT_L(n) asm volatile("s_waitcnt lgkmcnt(" #n ")" ::: "memory")
#define PG8_BAR __builtin_amdgcn_s_barrier()
#define PG8_SCHED __builtin_amdgcn_sched_barrier(0)
    Unit cur, nxt; int ui = 0;
    if (!S.next(0, cur)) return;
    f32x4 acc[2][2][4][2];
#pragma unroll
    for (int a = 0; a < 2; ++a)
#pragma unroll
        for (int b = 0; b < 2; ++b)
#pragma unroll
            for (int m = 0; m < 4; ++m)
#pragma unroll
                for (int n = 0; n < 2; ++n) acc[a][b][m][n] = (f32x4){0.f, 0.f, 0.f, 0.f};
    bf16x8 At[4][2], B0[2][2], B1[2][2];
    const char* cA = (const char*)g.A + (size_t)cur.pm * tstep; const char* cB = (const char*)g.Bt + (size_t)cur.pn * tstep;
    S.a_ready(cur);
    if constexpr (SP2) {
        PG8_STAGE(PG8_SB(0, 0), cB, voffB); PG8_STAGE(PG8_SB(0, 1), cB + hstep, voffB); PG8_STAGE(PG8_SA(0, 0), cA, voffA); PG8_STAGE(PG8_SA(0, 1), cA + hstep, voffA);
        if (wr == 1) PG8_BAR;
        PG8_WAIT_V(2); PG8_BAR;
        PG8_STAGE(PG8_SB(1, 0), cB + kstep, voffB); PG8_STAGE(PG8_SA(1, 0), cA + kstep, voffA); PG8_STAGE(PG8_SB(1, 1), cB + hstep + kstep, voffB);
        PG8_WAIT_V(6); PG8_BAR;
    } else {
        PG8_STAGE(PG8_SB(0, 0), cB, voffB); PG8_STAGE(PG8_SA(0, 0), cA, voffA); PG8_STAGE(PG8_SB(0, 1), cB + hstep, voffB); PG8_STAGE(PG8_SA(0, 1), cA + hstep, voffA);
        if (wr == 1) PG8_BAR;
        PG8_WAIT_V(4); PG8_BAR;
        PG8_STAGE(PG8_SB(1, 0), cB + kstep, voffB); PG8_STAGE(PG8_SA(1, 0), cA + kstep, voffA); PG8_STAGE(PG8_SB(1, 1), cB + hstep + kstep, voffB);
        PG8_WAIT_V(6); PG8_BAR;
    }
    for (;;) {
        const bool has_next = S.next(ui + 1, nxt);
        const char* nA = has_next ? (const char*)g.A + (size_t)nxt.pm * tstep : cA; const char* nB = has_next ? (const char*)g.Bt + (size_t)nxt.pn * tstep : cB;
        for (int t = 0; t < nt; t += 2) {
            const bool last = (t == nt - 2);
            const char* a1 = cA + (size_t)(t + 1) * kstep;
            const char* a2 = last ? nA : cA + (size_t)(t + 2) * kstep; const char* b2 = last ? nB : cB + (size_t)(t + 2) * kstep;
            const char* a3 = a2 + kstep; const char* b3 = b2 + kstep;
            if (last && has_next) S.a_ready(nxt);
            if constexpr (SP2) {
            PG8_LDB(B0, 0, 0); PG8_LDB(B1, 0, 1); PG8_SCHED; PG8_LDA(At, 0, 0); PG8_STAGE(PG8_SA(1, 1), a1 + hstep, voffA);
            PG8_WAIT_V(8); PG8_WAIT_L(0); PG8_BAR; PG8_MMA(0, 0, At, B0); PG8_MMA(0, 1, At, B1); PG8_BAR; PG8_SCHED;
            PG8_LDA(At, 0, 1); PG8_STAGE(PG8_SB(0, 0), b2, voffB); PG8_STAGE(PG8_SB(0, 1), b2 + hstep, voffB); PG8_STAGE(PG8_SA(0, 0), a2, voffA);
            PG8_WAIT_V(8); PG8_WAIT_L(0); PG8_BAR; PG8_MMA(1, 0, At, B0); PG8_MMA(1, 1, At, B1); PG8_BAR; PG8_SCHED;
            PG8_LDB(B0, 1, 0); PG8_LDB(B1, 1, 1); PG8_SCHED; PG8_LDA(At, 1, 0); PG8_STAGE(PG8_SA(0, 1), a2 + hstep, voffA);
            PG8_WAIT_V(8); PG8_WAIT_L(0); PG8_BAR; PG8_MMA(0, 0, At, B0); PG8_MMA(0, 1, At, B1); PG8_BAR; PG8_SCHED;
            PG8_LDA(At, 1, 1); PG8_STAGE(PG8_SB(1, 0), b3, voffB); PG8_STAGE(PG8_SB(1, 1), b3 + hstep, voffB); PG8_STAGE(PG8_SA(1, 0), a3, voffA);
            PG8_WAIT_V(8); PG8_WAIT_L(0); PG8_BAR; PG8_MMA(1, 0, At, B0); PG8_MMA(1, 1, At, B1); PG8_BAR; PG8_SCHED;
            } else {
            PG8_LDB(B0, 0, 0); PG8_SCHED; PG8_LDA(At, 0, 0); PG8_STAGE(PG8_SA(1, 1), a1 + hstep, voffA);
            PG8_WAIT_L(8); PG8_BAR; PG8_WAIT_L(0); PG8_MMA(0, 0, At, B0); PG8_BAR; PG8_SCHED;
            PG8_LDB(B1, 0, 1); PG8_STAGE(PG8_SB(0, 0), b2, voffB);
            PG8_BAR; PG8_WAIT_L(0); PG8_MMA(0, 1, At, B1); PG8_BAR;
            PG8_LDA(At, 0, 1); PG8_STAGE(PG8_SA(0, 0), a2, voffA);
            PG8_BAR; PG8_WAIT_L(0); PG8_MMA(1, 0, At, B0); PG8_BAR; PG8_SCHED;
            PG8_STAGE(PG8_SB(0, 1), b2 + hstep, voffB);
            PG8_WAIT_V(6); PG8_BAR; PG8_MMA(1, 1, At, B1); PG8_BAR;
            PG8_LDB(B0, 1, 0); PG8_SCHED; PG8_LDA(At, 1, 0); PG8_STAGE(PG8_SA(0, 1), a2 + hstep, voffA);
            PG8_WAIT_L(8); PG8_BAR; PG8_WAIT_L(0); PG8_MMA(0, 0, At, B0); PG8_BAR; PG8_SCHED;
            PG8_LDB(B1, 1, 1); PG8_STAGE(PG8_SB(1, 0), b3, voffB);
            PG8_BAR; PG8_WAIT_L(0); PG8_MMA(0, 1, At, B1); PG8_BAR;
            PG8_LDA(At, 1, 1); PG8_STAGE(PG8_SA(1, 0), a3, voffA);
            PG8_BAR; PG8_WAIT_L(0); PG8_MMA(1, 0, At, B0); PG8_BAR; PG8_SCHED;
            PG8_STAGE(PG8_SB(1, 1), b3 + hstep, voffB);
            PG8_WAIT_V(6); PG8_BAR; PG8_MMA(1, 1, At, B1); PG8_BAR;
            }
        }
        if constexpr (ALIGN_EPI) { if (wr == 0) PG8_BAR; }
        if constexpr (!Epi::AFTER_DRAIN) { E(acc, cur, wr, wc, fr, fq); S.done(cur); }
        if (!has_next) break;
#pragma unroll
        for (int a = 0; a < 2; ++a)
#pragma unroll
            for (int b = 0; b < 2; ++b)
#pragma unroll
                for (int m = 0; m < 4; ++m)
#pragma unroll
                    for (int n = 0; n < 2; ++n) acc[a][b][m][n] = (f32x4){0.f, 0.f, 0.f, 0.f};
        cur = nxt; cA = nA; cB = nB; ++ui;
        if constexpr (ALIGN_EPI) { if (wr == 1) PG8_BAR; }
    }
    PG8_WAIT_V(0);
    if constexpr (!ALIGN_EPI) { if (wr == 0) PG8_BAR; }
    PG8_BAR;
#undef PG8_SA
#undef PG8_SB
#undef PG8_STAGE
#undef PG8_LDA
#undef PG8_LDB
#undef PG8_MMA
#undef PG8_WAIT_V
#undef PG8_WAIT_L
#undef PG8_BAR
#undef PG8_SCHED
}
}

constexpr int NWAVES = 8, NTHR = 512;
constexpr int DM = 1024, NLAY = 4;
constexpr int PB = 8, PL = 2064, PT = PB * PL, SB = 128, SL = 8, ST = SB * SL, T = PT + ST, MP = 17664;
constexpr int NCH = 33;
constexpr int NIN = 3328;
constexpr int CQ = 0, CK = 256, CV = 512, CG = 1024, CZ = 1536, CX = 2048, CF = 3072, CDT = 3088;
constexpr int NGLA_P = PB * NCH * 4, NGLA_S = SB * 4, NGLA = NGLA_P + NGLA_S;
constexpr int NSSD_P = PB * NCH * 8, NSSD_S = SB * 8, NSSD = NSSD_P + NSSD_S;
constexpr float EPS = 1e-6f;
constexpr size_t O_YP = 0, O_YS = 16777216, O_GP = 17825792, O_SP = 18874368, O_CP = 20971520, O_GS = 21069824, O_SS = 37847040, O_CS = 71401472;

constexpr size_t al256(size_t x) { return (x + 255) & ~(size_t)255; }
constexpr size_t WS_CTL = 0, CTL_BYTES = 1u << 20;
constexpr size_t WS_WIN = WS_CTL + CTL_BYTES;
constexpr size_t WS_WOUT = WS_WIN + (size_t)NLAY * NIN * DM * 2;
constexpr size_t WS_WQ = WS_WOUT + (size_t)NLAY * DM * DM * 2;
constexpr size_t WS_UB = WS_WQ + (size_t)NLAY * DM * DM * 2;
constexpr size_t WS_VB = WS_UB + (size_t)NLAY * 16384 * DM;
constexpr size_t WS_US = WS_VB + (size_t)NLAY * 16384 * DM;
constexpr size_t WS_VS = WS_US + (size_t)NLAY * 16384 * 4;
constexpr size_t WS_H = WS_VS + (size_t)NLAY * 16384 * 4;
constexpr size_t WS_HB = WS_H + (size_t)MP * DM * 4;
constexpr size_t WS_PROJ = WS_HB + (size_t)MP * DM * 2;
constexpr size_t WS_MIX = WS_PROJ + (size_t)MP * NIN * 2;
constexpr size_t WS_Q = WS_MIX + (size_t)MP * DM * 2;
constexpr size_t WS_SSQ1 = WS_Q + (size_t)MP * DM * 2;
constexpr size_t WS_SSQ2 = al256(WS_SSQ1 + (size_t)MP * 4);
constexpr size_t WS_RE = al256(WS_SSQ2 + (size_t)MP * 16 * 4);
constexpr size_t WS_RG = al256(WS_RE + (size_t)T * 128 * 4);
constexpr size_t WS_SG = al256(WS_RG + (size_t)T * 128 * 4);
constexpr size_t WS_DG = al256(WS_SG + (size_t)NGLA * 8192 * 4);
constexpr size_t WS_SS = al256(WS_DG + (size_t)NGLA * 64 * 4);
constexpr size_t WS_DS = al256(WS_SS + (size_t)NSSD * 8192 * 4);
constexpr size_t WS_BC = al256(WS_DS + (size_t)NSSD * 4);
constexpr size_t WS_XC = al256(WS_BC + (size_t)NGLA * 4096 * 4);
constexpr size_t WS_X8 = al256(WS_XC + (size_t)MP * 1024 * 2);
constexpr size_t WS_HS = al256(WS_X8 + (size_t)64 * T * 16);
constexpr size_t WS_PL = al256(WS_HS + (size_t)T * 4);
constexpr size_t WS_WP = al256(WS_PL + (size_t)256 * 10240 * 4);
constexpr size_t WS_END = al256(WS_WP + (size_t)T * 128 * 4);
constexpr int CW_BAR = 4096, CW_Q = 8192, CW_GC = 16384;

constexpr int LDS_BYTES = 163840;
constexpr int MISC_OFF = 163840 - 256;

typedef unsigned short bf16;
typedef float f32x4 __attribute__((ext_vector_type(4)));
typedef unsigned u32x4 __attribute__((ext_vector_type(4)));
typedef unsigned u32x2 __attribute__((ext_vector_type(2)));
#define LAS __attribute__((address_space(3)))

__device__ __forceinline__ float bf2f(unsigned short u) { return __uint_as_float(((unsigned)u) << 16); }
__device__ __forceinline__ float bflo(unsigned u) { return __uint_as_float(u << 16); }
__device__ __forceinline__ float bfhi(unsigned u) { return __uint_as_float(u & 0xffff0000u); }
typedef __bf16 bf16n2 __attribute__((ext_vector_type(2)));
typedef float f32p2 __attribute__((ext_vector_type(2)));
__device__ __forceinline__ unsigned f2bf(float f) { const __bf16 b = (__bf16)f; return (unsigned)__builtin_bit_cast(unsigned short, b); }
__device__ __forceinline__ unsigned pk2(float lo, float hi) { const f32p2 v = (f32p2){lo, hi}; const bf16n2 b = __builtin_convertvector(v, bf16n2); return __builtin_bit_cast(unsigned, b); }
__device__ __forceinline__ float siluf(float x) { return x * __builtin_amdgcn_rcpf(1.0f + __expf(-x)); }

#define XB_TMO      128
#define XB_XCNT(j)  (256  + 64 * (j))
#define XB_XSUB(j)  (1280 + 64 * (j))
#define XB_XGEN(j)  (2304 + 64 * (j))
#define XB_TOP      3328
#define XB_TOPGEN   3392
#define XCD_BAR_WORDS 3456
#define XB_SPIN_CAP (1u << 22)
__device__ __forceinline__ unsigned xb_ld(unsigned* p)              { return __hip_atomic_load(p, __ATOMIC_RELAXED, __HIP_MEMORY_SCOPE_AGENT); }
__device__ __forceinline__ unsigned xb_add(unsigned* p, unsigned v) { return __hip_atomic_fetch_add(p, v, __ATOMIC_RELAXED, __HIP_MEMORY_SCOPE_AGENT); }
__device__ __forceinline__ unsigned xb_xcc_id() { return (unsigned)__builtin_amdgcn_s_getreg((3 << 11) | 20) & 0xFu; }
#define XB_SPIN(cond, bar) do { unsigned _sp = 0; while (cond) { __builtin_amdgcn_s_sleep(1); \
    if ((++_sp & 255u) == 0u) { if (xb_ld(&(bar)[XB_TMO])) break; if (_sp > XB_SPIN_CAP) { atomicAdd(&(bar)[XB_TMO], 1u); break; } } } } while (0)
struct XcdBarrier { unsigned* bar; unsigned x; volatile LAS unsigned* st; };
__device__ __forceinline__ XcdBarrier xcd_barrier_post(unsigned* bar, volatile LAS unsigned* st) {
    XcdBarrier b; b.bar = bar; b.x = xb_xcc_id(); b.st = st;
    if (threadIdx.x == 0) (void)xb_add(&bar[XB_XCNT(b.x)], 1u);
    return b;
}
__device__ __forceinline__ void xcd_barrier_complete(unsigned* bar, unsigned x, unsigned& nloc, unsigned& nx) {
    const unsigned G = gridDim.x * gridDim.y * gridDim.z;
    unsigned sum, cnt, mine, sp = 0u;
    for (;;) {
        sum = 0u; cnt = 0u; mine = 0u;
#pragma unroll
        for (unsigned j = 0; j < 16; ++j) { const unsigned c = xb_ld(&bar[XB_XCNT(j)]); sum += c; cnt += (c > 0u) ? 1u : 0u; mine = (j == x) ? c : mine; }
        if (sum == G) break;
        __builtin_amdgcn_s_sleep(1);
        if ((++sp & 255u) == 0u) { if (xb_ld(&bar[XB_TMO])) break; if (sp > XB_SPIN_CAP) { atomicAdd(&bar[XB_TMO], 1u); break; } }
    }
    nloc = mine > 0u ? mine : 1u; nx = cnt > 0u ? cnt : 1u;
}
__device__ __forceinline__ void xcd_barrier(const XcdBarrier& b) {
    asm volatile("s_waitcnt vmcnt(0)" ::: "memory");
    __syncthreads();
    if (threadIdx.x == 0) {
        unsigned* bar = b.bar;
        __builtin_amdgcn_s_waitcnt(0);
        unsigned nloc = b.st[0], nx = b.st[1];
        if (nloc == 0u) { xcd_barrier_complete(bar, b.x, nloc, nx); b.st[0] = nloc; b.st[1] = nx; }
        const unsigned old = xb_add(&bar[XB_XSUB(b.x)], 1u);
        const unsigned gen = old / nloc;
        if (old + 1u == (gen + 1u) * nloc) {
            __builtin_amdgcn_fence(__ATOMIC_RELEASE, "agent");
            asm volatile("s_waitcnt vmcnt(0)" ::: "memory");
            const unsigned og = xb_add(&bar[XB_TOP], 1u);
            const unsigned tg = og / nx;
            if (og + 1u == (tg + 1u) * nx) xb_add(&bar[XB_TOPGEN], 1u);
            else XB_SPIN(xb_ld(&bar[XB_TOPGEN]) == tg, bar);
            __builtin_amdgcn_fence(__ATOMIC_ACQUIRE, "agent");
            xb_add(&bar[XB_XGEN(b.x)], 1u);
            asm volatile("s_waitcnt vmcnt(0)" ::: "memory");
        } else {
            XB_SPIN(xb_ld(&bar[XB_XGEN(b.x)]) == gen, bar);
            __builtin_amdgcn_fence(__ATOMIC_ACQUIRE, "agent");
            asm volatile("s_waitcnt vmcnt(0)" ::: "memory");
        }
    }
    __syncthreads();
}

struct Args { const float* in[25]; float* out; unsigned char* ws; int ph_lo, ph_hi; int rep[10]; };
#ifndef PROBE_REP
#define PROBE_REP {1, 1, 1, 1, 1, 1, 1, 1, 1, 1}
#endif
enum { I_XP = 0, I_XS, I_SGLA, I_SSSM, I_SCONV, I_META, I_N1W, I_WIN, I_WGK2, I_BGK2, I_GLANW, I_CONVW, I_CONVB, I_DTB, I_ALOG, I_DSKIP, I_SSDNW, I_WOUT, I_N2W, I_WQ, I_K1, I_K2, I_U, I_V, I_FNW };

#define WR_DPP(x, ctrl, rmask, bc) __int_as_float(__builtin_amdgcn_update_dpp(0, __float_as_int(x), ctrl, rmask, 0xF, bc))
__device__ __forceinline__ float wave_sum(float v) {
    v += WR_DPP(v, 0x111, 0xF, true); v += WR_DPP(v, 0x112, 0xF, true); v += WR_DPP(v, 0x114, 0xF, true); v += WR_DPP(v, 0x118, 0xF, true);
    v += WR_DPP(v, 0x142, 0xA, false); v += WR_DPP(v, 0x143, 0xC, false);
    return __int_as_float(__builtin_amdgcn_readlane(__float_as_int(v), 63));
}
__device__ __forceinline__ float wave_max_nonneg(float v) {
    v = fmaxf(v, WR_DPP(v, 0x111, 0xF, true)); v = fmaxf(v, WR_DPP(v, 0x112, 0xF, true)); v = fmaxf(v, WR_DPP(v, 0x114, 0xF, true)); v = fmaxf(v, WR_DPP(v, 0x118, 0xF, true));
    v = fmaxf(v, WR_DPP(v, 0x142, 0xA, false)); v = fmaxf(v, WR_DPP(v, 0x143, 0xC, false));
    return __int_as_float(__builtin_amdgcn_readlane(__float_as_int(v), 63));
}

__device__ __forceinline__ int win_orig_col(int n) {
    if (n < 1536) return n;
    if (n < 3072) return n + 16;
    if (n < 3088) return n - 3072 + 1536;
    if (n < 3096) return n;
    return -1;
}
template <int MODE>
__device__ __forceinline__ void p0_transpose_item(const float* W, int N, const float* rowscale, bf16* WT, LAS float* scr, int item, int nblk, int lane) {
    const int kb = item / nblk, nb = item % nblk, k0 = 64 * kb, n0 = 32 * nb;
    const int nn = n0 + (lane & 31);
    const int oc = MODE == 0 ? win_orig_col(nn) : nn;
    const float cs = (MODE == 0 && nn < 256) ? 0.125f : 1.0f;
    float wv[32];
#pragma unroll
    for (int i = 0; i < 32; ++i) { const int kk = 2 * i + (lane >> 5); wv[i] = (oc >= 0) ? W[(size_t)(k0 + kk) * N + oc] : 0.f; }
#pragma unroll
    for (int i = 0; i < 32; ++i) { const int kk = 2 * i + (lane >> 5);
        float v = wv[i] * cs; if (rowscale) v *= rowscale[k0 + kk];
        scr[kk * 33 + (lane & 31)] = v; }
    asm volatile("s_waitcnt lgkmcnt(0)" ::: "memory");
    const int c = lane & 7;
#pragma unroll
    for (int j = 0; j < 4; ++j) { const int n = (lane >> 3) + 8 * j; const LAS float* s = scr + (8 * c) * 33 + n;
        u32x4 o; o.x = pk2(s[0 * 33], s[1 * 33]); o.y = pk2(s[2 * 33], s[3 * 33]); o.z = pk2(s[4 * 33], s[5 * 33]); o.w = pk2(s[6 * 33], s[7 * 33]);
        *(u32x4*)(WT + (size_t)(n0 + n) * 1024 + k0 + 8 * c) = o; }
    asm volatile("s_waitcnt lgkmcnt(0)" ::: "memory");
}

__device__ __forceinline__ void quant_u_layer(const Args& a, int l, int gw, int NGW) {
    const int lane = opaque_tid() & 63; unsigned char* ws = a.ws;
    for (int gi = gw; gi < 4096; gi += NGW) {
        const int i1 = gi >> 5, c0 = (gi >> 1) & 15, jh = gi & 1;
        const int eb = (i1 + c0) & 15, el0 = (i1 << 3) | (4 * jh);
        f32x4 x[4][4];
        const float* nw = a.in[I_N2W] + l * DM + lane * 16;
        const f32x4 n0 = *(const f32x4*)nw, n1 = *(const f32x4*)(nw + 4), n2 = *(const f32x4*)(nw + 8), n3 = *(const f32x4*)(nw + 12);
#pragma unroll
        for (int z = 0; z < 4; ++z) { const int e = i1 * 128 + 16 * (4 * jh + z) + c0; const float* src = a.in[I_U] + ((size_t)l * 16384 + e) * DM + lane * 16;
            x[z][0] = *(const f32x4*)src * n0; x[z][1] = *(const f32x4*)(src + 4) * n1; x[z][2] = *(const f32x4*)(src + 8) * n2; x[z][3] = *(const f32x4*)(src + 12) * n3; }
        u32x4 wq[4];
#pragma unroll
        for (int z = 0; z < 4; ++z) {
            float am = 0.f;
#pragma unroll
            for (int j = 0; j < 4; ++j) am = fmaxf(fmaxf(am, fmaxf(fabsf(x[z][j][0]), fabsf(x[z][j][1]))), fmaxf(fabsf(x[z][j][2]), fabsf(x[z][j][3])));
            am = wave_max_nonneg(am);
            const float sc = am > 0.f ? am * (1.0f / 127.0f) : 1.0f, inv = 1.0f / sc;
            unsigned wv[4];
#pragma unroll
            for (int j = 0; j < 4; ++j) { const int q0 = (int)rintf(x[z][j][0] * inv), q1 = (int)rintf(x[z][j][1] * inv), q2 = (int)rintf(x[z][j][2] * inv), q3 = (int)rintf(x[z][j][3] * inv);
                wv[j] = (unsigned)(q0 & 255) | ((unsigned)(q1 & 255) << 8) | ((unsigned)(q2 & 255) << 16) | ((unsigned)(q3 & 255) << 24); }
            wq[z] = (u32x4){wv[0], wv[1], wv[2], wv[3]};
            if (lane == 0) ((float*)(ws + WS_US))[l * 16384 + i1 * 128 + 16 * (4 * jh + z) + c0] = sc;
        }
        u32x4* dst = (u32x4*)(ws + WS_UB + ((size_t)(l * 64 + lane) * 16384 + (size_t)eb * 1024 + el0) * 16);
        dst[0] = wq[0]; dst[1] = wq[1]; dst[2] = wq[2]; dst[3] = wq[3];
    }
}
__device__ __forceinline__ void quant_v_layer(const Args& a, int l, int r_lo, int r_hi, int gw, int NGW) {
    const int lane = opaque_tid() & 63; unsigned char* ws = a.ws;
    for (int row0 = r_lo + gw; row0 < r_hi; row0 += 2 * NGW) {
        f32x4 x[2][4]; int rrv[2];
#pragma unroll
        for (int z = 0; z < 2; ++z) { const int row = row0 + z * NGW; const bool live = row < r_hi; const int rr = l * 16384 + (live ? row : r_lo); rrv[z] = live ? rr : -1;
            const float* src = a.in[I_V] + (size_t)rr * DM + lane * 16;
#pragma unroll
            for (int j = 0; j < 4; ++j) x[z][j] = *(const f32x4*)(src + 4 * j); }
#pragma unroll
        for (int z = 0; z < 2; ++z) {
            float am = 0.f;
#pragma unroll
            for (int j = 0; j < 4; ++j) am = fmaxf(fmaxf(am, fmaxf(fabsf(x[z][j][0]), fabsf(x[z][j][1]))), fmaxf(fabsf(x[z][j][2]), fabsf(x[z][j][3])));
            am = wave_max_nonneg(am);
            const float sc = am > 0.f ? am * (1.0f / 127.0f) : 1.0f, inv = 1.0f / sc;
            unsigned wv[4];
#pragma unroll
            for (int j = 0; j < 4; ++j) { const int q0 = (int)rintf(x[z][j][0] * inv) + 128, q1 = (int)rintf(x[z][j][1] * inv) + 128, q2 = (int)rintf(x[z][j][2] * inv) + 128, q3 = (int)rintf(x[z][j][3] * inv) + 128;
                wv[j] = (unsigned)(q0 & 255) | ((unsigned)(q1 & 255) << 8) | ((unsigned)(q2 & 255) << 16) | ((unsigned)(q3 & 255) << 24); }
            if (rrv[z] >= 0) {
                *(u32x4*)(ws + WS_VB + (size_t)rrv[z] * DM + lane * 16) = (u32x4){wv[0], wv[1], wv[2], wv[3]};
                if (lane == 0) ((float*)(ws + WS_VS))[rrv[z]] = sc; }
        }
    }
}

__device__ __forceinline__ void phase_prologue(const Args& a, LAS unsigned char* lds) {
    const int tid = opaque_tid(), lane = tid & 63, wave = tid >> 6;
    const int G = gridDim.x, gw = blockIdx.x * NWAVES + wave, NGW = G * NWAVES;
    unsigned char* ws = a.ws;
    LAS float* scr = (LAS float*)(lds + wave * 16384);
    {
        constexpr int NB_IN = NIN / 32, IT_IN = 16 * NB_IN, NB_SQ = 32, IT_SQ = 16 * NB_SQ;
        constexpr int PER_LAYER = IT_IN + 2 * IT_SQ;
        for (int it = gw; it < NLAY * PER_LAYER; it += NGW) {
            const int l = it / PER_LAYER; int r = it % PER_LAYER;
            if (r < IT_IN) { p0_transpose_item<0>(a.in[I_WIN] + (size_t)l * DM * 3096, 3096, a.in[I_N1W] + l * DM, (bf16*)(ws + WS_WIN) + (size_t)l * NIN * DM, scr, r, NB_IN, lane); continue; }
            r -= IT_IN;
            if (r < IT_SQ) { p0_transpose_item<1>(a.in[I_WOUT] + (size_t)l * DM * DM, DM, nullptr, (bf16*)(ws + WS_WOUT) + (size_t)l * DM * DM, scr, r, NB_SQ, lane); continue; }
            r -= IT_SQ;
            p0_transpose_item<1>(a.in[I_WQ] + (size_t)l * DM * DM, DM, a.in[I_N2W] + l * DM, (bf16*)(ws + WS_WQ) + (size_t)l * DM * DM, scr, r, NB_SQ, lane);
        }
    }
    {
        float* H = (float*)(ws + WS_H); bf16* HB = (bf16*)(ws + WS_HB); float* SSQ1 = (float*)(ws + WS_SSQ1);
        for (int r = gw; r < MP; r += NGW) {
            f32x4 v[4]; float ss = 0.f;
            const float* src = nullptr;
            if (r < PT) { const int b = r / PL, t = r % PL; src = (t < 16) ? a.in[I_META] + (size_t)t * DM : a.in[I_XP] + ((size_t)b * 2048 + (t - 16)) * DM; }
            else if (r < T) src = a.in[I_XS] + (size_t)(r - PT) * DM;
#pragma unroll
            for (int j = 0; j < 4; ++j) { v[j] = src ? *(const f32x4*)(src + 256 * j + 4 * lane) : (f32x4){0.f, 0.f, 0.f, 0.f};
                ss += (v[j][0] * v[j][0] + v[j][1] * v[j][1]) + (v[j][2] * v[j][2] + v[j][3] * v[j][3]); }
            ss = wave_sum(ss);
#pragma unroll
            for (int j = 0; j < 4; ++j) { *(f32x4*)(H + (size_t)r * DM + 256 * j + 4 * lane) = v[j];
                u32x2 w; w.x = pk2(v[j][0], v[j][1]); w.y = pk2(v[j][2], v[j][3]); *(u32x2*)(HB + (size_t)r * DM + 256 * j + 4 * lane) = w; }
            if (lane == 0) SSQ1[r] = ss;
        }
    }
}

struct ItemG { int g, b, n, h, L, row0, t0, nv; };
__device__ __forceinline__ ItemG decode_gla(int item) {
    ItemG it;
    if (item < NGLA_P) { it.g = 0; it.h = item & 3; const int bn = item >> 2; it.n = bn % NCH; it.b = bn / NCH; it.L = PL; it.row0 = it.b * PL; }
    else { const int j = item - NGLA_P; it.g = 1; it.h = j & 3; it.b = j >> 2; it.n = 0; it.L = SL; it.row0 = PT + it.b * SL; }
    it.t0 = it.n * 64; it.nv = min(64, it.L - it.t0); return it;
}
__device__ __forceinline__ ItemG decode_ssd(int item) {
    ItemG it;
    if (item < NSSD_P) { it.g = 0; it.h = item & 7; const int bn = item >> 3; it.n = bn % NCH; it.b = bn / NCH; it.L = PL; it.row0 = it.b * PL; }
    else { const int j = item - NSSD_P; it.g = 1; it.h = j & 7; it.b = j >> 3; it.n = 0; it.L = SL; it.row0 = PT + it.b * SL; }
    it.t0 = it.n * 64; it.nv = min(64, it.L - it.t0); return it;
}
typedef short bf16x8 __attribute__((ext_vector_type(8)));
__device__ __forceinline__ f32x4 mfma16(bf16x8 a, bf16x8 b, f32x4 c) { return __builtin_amdgcn_mfma_f32_16x16x32_bf16(a, b, c, 0, 0, 0); }
__device__ __forceinline__ float wave_scan_incl(float v, int lane) {
    (void)lane;
#define WS_DPP(x, ctrl, rmask, bc) __int_as_float(__builtin_amdgcn_update_dpp(0, __float_as_int(x), ctrl, rmask, 0xF, bc))
    v += WS_DPP(v, 0x111, 0xF, true);
    v += WS_DPP(v, 0x112, 0xF, true);
    v += WS_DPP(v, 0x114, 0xF, true);
    v += WS_DPP(v, 0x118, 0xF, true);
    v += WS_DPP(v, 0x142, 0xA, false);
    v += WS_DPP(v, 0x143, 0xC, false);
#undef WS_DPP
    return v;
}
__device__ __forceinline__ void unpack8(const u32x4 r, float* o) { o[0] = bflo(r.x); o[1] = bfhi(r.x); o[2] = bflo(r.y); o[3] = bfhi(r.y); o[4] = bflo(r.z); o[5] = bfhi(r.z); o[6] = bflo(r.w); o[7] = bfhi(r.w); }
__device__ __forceinline__ u32x4 pack8(const float* f) { return (u32x4){pk2(f[0], f[1]), pk2(f[2], f[3]), pk2(f[4], f[5]), pk2(f[6], f[7])}; }
__device__ __forceinline__ float softplusf(float x) { return fmaxf(x, 0.f) + __logf(1.0f + __expf(-fabsf(x))); }

__device__ __forceinline__ int tsw(int r, int t) { return r * 72 + (((((t >> 3) ^ (r >> 4)) & 7) << 3) | (t & 7)); }
__device__ __forceinline__ int fsw(int tile, int ks, int q) { return (((4 * ks + q) ^ tile) & 7) << 3; }
__device__ __forceinline__ void conv_silu8(const Args& a, int l, const ItemG& it, int ts, int cc0, float* o) {
    const bf16* P = (const bf16*)(a.ws + WS_PROJ);
    const float* cbp = a.in[I_CONVB] + l * 1024 + cc0;
    const f32x4 b0 = *(const f32x4*)cbp, b1 = *(const f32x4*)(cbp + 4);
    float acc[8] = {b0[0], b0[1], b0[2], b0[3], b1[0], b1[1], b1[2], b1[3]};
#pragma unroll
    for (int i = 0; i < 4; ++i) {
        const int tt = ts - 3 + i; float xv[8];
        if (tt >= 0) { const u32x4 r = *(const u32x4*)(P + (size_t)(it.row0 + tt) * NIN + CX + cc0); unpack8(r, xv); }
        else if (it.g) { const float* sp = a.in[I_SCONV] + ((size_t)(l * SB + it.b) * 3 + (tt + 3)) * 1024 + cc0; const f32x4 s0 = *(const f32x4*)sp, s1 = *(const f32x4*)(sp + 4);
            xv[0] = s0[0]; xv[1] = s0[1]; xv[2] = s0[2]; xv[3] = s0[3]; xv[4] = s1[0]; xv[5] = s1[1]; xv[6] = s1[2]; xv[7] = s1[3]; }
        else {
#pragma unroll
            for (int j = 0; j < 8; ++j) xv[j] = 0.f; }
        const float* wp = a.in[I_CONVW] + (size_t)(l * 4 + i) * 1024 + cc0; const f32x4 w0 = *(const f32x4*)wp, w1 = *(const f32x4*)(wp + 4);
        acc[0] += w0[0] * xv[0]; acc[1] += w0[1] * xv[1]; acc[2] += w0[2] * xv[2]; acc[3] += w0[3] * xv[3];
        acc[4] += w1[0] * xv[4]; acc[5] += w1[1] * xv[5]; acc[6] += w1[2] * xv[6]; acc[7] += w1[3] * xv[7];
    }
#pragma unroll
    for (int j = 0; j < 8; ++j) o[j] = siluf(acc[j]);
}

__device__ __forceinline__ void gates_load(const Args& a, int l, const ItemG& it, float* fl, float* wg, float* bg, int tid) {
    const bf16* P = (const bf16*)(a.ws + WS_PROJ) + (size_t)(it.row0 + it.t0) * NIN;
    if (tid < 128) {
        const int t = tid >> 1, r0 = (tid & 1) * 8;
        u32x4 r = (u32x4){0u, 0u, 0u, 0u};
        if (t < it.nv) r = *(const u32x4*)(P + (size_t)t * NIN + CF + r0);
        unpack8(r, fl + t * 16 + r0);
    }
    const float* W = a.in[I_WGK2] + (size_t)l * 16 * 256;
    for (int i = tid; i < 1024; i += NTHR) { const int r = i >> 6, d = i & 63; wg[i] = W[r * 256 + it.h * 64 + d]; }
    if (tid < 64) bg[tid] = a.in[I_BGK2][l * 256 + it.h * 64 + tid];
}
__device__ __forceinline__ void gates_gk(const ItemG& it, float* bc, const float* fl, const float* wg, const float* bg, int tid) {
    const int d = tid & 63, t0 = tid >> 6;
    float wr[16];
#pragma unroll
    for (int r = 0; r < 16; ++r) wr[r] = wg[r * 64 + d];
    const float b0 = bg[d];
#pragma unroll
    for (int i = 0; i < 8; ++i) { const int t = t0 + 8 * i;
        const f32x4 f0 = *(const f32x4*)(fl + t * 16), f1 = *(const f32x4*)(fl + t * 16 + 4), f2 = *(const f32x4*)(fl + t * 16 + 8), f3 = *(const f32x4*)(fl + t * 16 + 12);
        float x = b0;
#pragma unroll
        for (int r = 0; r < 4; ++r) { x += f0[r] * wr[r]; x += f1[r] * wr[4 + r]; x += f2[r] * wr[8 + r]; x += f3[r] * wr[12 + r]; }
        const float ls = fminf(x, 0.f) - __logf(1.0f + __expf(-fabsf(x)));
        bc[t * 65 + d] = (t < it.nv) ? ls * (1.0f / 16.0f) : 0.f; }
}
__device__ __forceinline__ void gates_scan(float* bc, int tid) {
    const int lane = tid & 63, w = tid >> 6;
#pragma unroll
    for (int i = 0; i < 8; ++i) { const int d = w * 8 + i; float v = bc[lane * 65 + d]; v = wave_scan_incl(v, lane); bc[lane * 65 + d] = v; }
}

template <int NB>
__device__ __forceinline__ void r1_gla_b(const Args& a, int l, int item0, float* lds) {
    const int tid = opaque_tid(), lane = tid & 63, w = tid >> 6, c = lane & 15, q = lane >> 4;
    constexpr int SZ = 34304;
    const int t = tid >> 3, j8 = tid & 7;
    ItemG it[NB]; u32x4 rk[NB], rv[NB][2];
#pragma unroll
    for (int u = 0; u < NB; ++u) {
        it[u] = decode_gla(item0 + u);
        float* bc = (float*)((unsigned char*)lds + u * SZ); float* fl = bc + 64 * 65; float* wg = fl + 1024; float* bg = wg + 1024;
        const bf16* P = (const bf16*)(a.ws + WS_PROJ) + (size_t)(it[u].row0 + it[u].t0) * NIN;
        rk[u] = (u32x4){0u, 0u, 0u, 0u}; rv[u][0] = rk[u]; rv[u][1] = rk[u];
        if (t < it[u].nv) { rk[u] = *(const u32x4*)(P + (size_t)t * NIN + CK + it[u].h * 64 + j8 * 8);
            rv[u][0] = *(const u32x4*)(P + (size_t)t * NIN + CV + it[u].h * 128 + j8 * 16); rv[u][1] = *(const u32x4*)(P + (size_t)t * NIN + CV + it[u].h * 128 + j8 * 16 + 8); }
        gates_load(a, l, it[u], fl, wg, bg, tid);
    }
    __syncthreads();
#pragma unroll
    for (int u = 0; u < NB; ++u) { float* bc = (float*)((unsigned char*)lds + u * SZ); gates_gk(it[u], bc, bc + 64 * 65, bc + 64 * 65 + 1024, bc + 64 * 65 + 2048, tid); }
    __syncthreads();
#pragma unroll
    for (int u = 0; u < NB; ++u) gates_scan((float*)((unsigned char*)lds + u * SZ), tid);
    __syncthreads();
#pragma unroll
    for (int u = 0; u < NB; ++u) {
        float* bc = (float*)((unsigned char*)lds + u * SZ); bf16* KT = (bf16*)(bc + 64 * 65 + 2048 + 64);
        const int d0 = j8 * 8;
        float kf[8], bv[8]; unpack8(rk[u], kf);
#pragma unroll
        for (int i = 0; i < 8; ++i) { const int d = d0 + i; bv[i] = bc[t * 65 + d]; KT[tsw(d, t)] = (bf16)f2bf(kf[i] * __expf(bc[63 * 65 + d] - bv[i])); }
        float* BCg = (float*)(a.ws + WS_BC) + (size_t)(item0 + u) * 4096 + t * 64 + d0;
        *(f32x4*)BCg = (f32x4){bv[0], bv[1], bv[2], bv[3]}; *(f32x4*)(BCg + 4) = (f32x4){bv[4], bv[5], bv[6], bv[7]};
        if (tid < 64) ((float*)(a.ws + WS_DG))[(size_t)(item0 + u) * 64 + tid] = __expf(bc[63 * 65 + tid]);
    }
    __syncthreads();
#pragma unroll
    for (int u = 0; u < NB; ++u) {
        bf16* VT = (bf16*)((unsigned char*)lds + u * SZ);
        const unsigned wv[8] = {rv[u][0].x, rv[u][0].y, rv[u][0].z, rv[u][0].w, rv[u][1].x, rv[u][1].y, rv[u][1].z, rv[u][1].w};
#pragma unroll
        for (int i = 0; i < 16; ++i) VT[tsw(j8 * 16 + i, t)] = (bf16)((i & 1) ? (wv[i >> 1] >> 16) : (wv[i >> 1] & 0xffffu));
    }
    __syncthreads();
#pragma unroll
    for (int u = 0; u < NB; ++u) {
        const bf16* VT = (const bf16*)((unsigned char*)lds + u * SZ); const bf16* KT = (const bf16*)((unsigned char*)lds + u * SZ + 25088);
        const int nks = (it[u].nv + 31) >> 5;
        bf16* SG = (bf16*)(a.ws + WS_SG) + (size_t)(item0 + u) * 8192;
        bf16x8 vf[2];
#pragma unroll
        for (int ks = 0; ks < 2; ++ks) vf[ks] = *(const bf16x8*)(VT + (16 * w + c) * 72 + fsw(w, ks, q));
#pragma unroll
        for (int dt = 0; dt < 4; ++dt) {
            f32x4 acc = (f32x4){0.f, 0.f, 0.f, 0.f};
#pragma unroll
            for (int ks = 0; ks < 2; ++ks) if (ks < nks) { const bf16x8 af = *(const bf16x8*)(KT + (16 * dt + c) * 72 + fsw(dt, ks, q)); acc = mfma16(vf[ks], af, acc); }
            *(u32x2*)(SG + (16 * dt + c) * 128 + 16 * w + 4 * q) = (u32x2){pk2(acc[0], acc[1]), pk2(acc[2], acc[3])};
        }
    }
}

template <int NB>
__device__ __forceinline__ void r1_ssd_b(const Args& a, int l, int item0, float* lds) {
    const int tid = opaque_tid(), lane = tid & 63, w = tid >> 6, c = lane & 15, q = lane >> 4;
    constexpr int SZ = 28160;
    static_assert(NB <= 8, "one wave per item scans dt");
    const int t = tid >> 3, j8 = tid & 7;
    ItemG it[NB]; float xv[NB][8], bv[NB][16];
#pragma unroll
    for (int u = 0; u < NB; ++u) {
        it[u] = decode_ssd(item0 + u);
        const int hd = it[u].h, gr = hd >> 2;
        float* dtv = (float*)((unsigned char*)lds + u * SZ);
        if (t < it[u].nv) { conv_silu8(a, l, it[u], it[u].t0 + t, hd * 64 + j8 * 8, xv[u]); conv_silu8(a, l, it[u], it[u].t0 + t, 512 + gr * 128 + j8 * 16, bv[u]); conv_silu8(a, l, it[u], it[u].t0 + t, 512 + gr * 128 + j8 * 16 + 8, bv[u] + 8); }
        else {
#pragma unroll
            for (int i = 0; i < 8; ++i) { xv[u][i] = 0.f; bv[u][i] = 0.f; bv[u][8 + i] = 0.f; } }
        if (tid < 64) { const bf16* P = (const bf16*)(a.ws + WS_PROJ);
            dtv[tid] = (tid < it[u].nv) ? softplusf(bf2f(P[(size_t)(it[u].row0 + it[u].t0 + tid) * NIN + CDT + hd]) + a.in[I_DTB][l * 8 + hd]) : 0.f; }
    }
    __syncthreads();
#pragma unroll
    for (int u = 0; u < NB; ++u) if (w == u) { float* dtv = (float*)((unsigned char*)lds + u * SZ); const float aa = -__expf(a.in[I_ALOG][l * 8 + it[u].h]); dtv[64 + lane] = wave_scan_incl(dtv[lane] * aa, lane); }
    __syncthreads();
#pragma unroll
    for (int u = 0; u < NB; ++u) {
        float* dtv = (float*)((unsigned char*)lds + u * SZ); const float* cum = dtv + 64; bf16* XT = (bf16*)(dtv + 128); bf16* BT = XT + 64 * 72;
        const float sc = __expf(cum[63] - cum[t]) * dtv[t];
#pragma unroll
        for (int i = 0; i < 8; ++i) XT[(j8 * 8 + i) * 72 + t] = (bf16)f2bf(xv[u][i] * sc);
#pragma unroll
        for (int i = 0; i < 16; ++i) BT[(j8 * 16 + i) * 72 + t] = (bf16)f2bf(bv[u][i]);
    }
    __syncthreads();
#pragma unroll
    for (int u = 0; u < NB; ++u) {
        const float* dtv = (const float*)((unsigned char*)lds + u * SZ); const bf16* XT = (const bf16*)(dtv + 128); const bf16* BT = XT + 64 * 72;
        const int nks = (it[u].nv + 31) >> 5;
        float* SS = (float*)(a.ws + WS_SS) + (size_t)(item0 + u) * 8192;
#pragma unroll
        for (int pt = 0; pt < 4; ++pt) {
            f32x4 acc = (f32x4){0.f, 0.f, 0.f, 0.f};
#pragma unroll
            for (int ks = 0; ks < 2; ++ks) if (ks < nks) {
                const bf16x8 af = *(const bf16x8*)(XT + (16 * pt + c) * 72 + 32 * ks + 8 * q);
                const bf16x8 bfr = *(const bf16x8*)(BT + (16 * w + c) * 72 + 32 * ks + 8 * q);
                acc = mfma16(af, bfr, acc); }
#pragma unroll
            for (int r = 0; r < 4; ++r) SS[(16 * pt + 4 * q + r) * 128 + 16 * w + c] = acc[r];
        }
        if (tid == 0) ((float*)(a.ws + WS_DS))[item0 + u] = __expf(dtv[64 + 63]);
    }
    __syncthreads();
}

__device__ __forceinline__ void conv_taps(const Args& a, int l, const ItemG& it, int ts, int cc0, u32x4 (&raw)[4]) {
    const bf16* P = (const bf16*)(a.ws + WS_PROJ);
#pragma unroll
    for (int i = 0; i < 4; ++i) {
        const int tt = ts - 3 + i;
        if (tt >= 0) raw[i] = *(const u32x4*)(P + (size_t)(it.row0 + tt) * NIN + CX + cc0);
        else if (it.g) { const float* sp = a.in[I_SCONV] + ((size_t)(l * SB + it.b) * 3 + (tt + 3)) * 1024 + cc0; const f32x4 s0 = *(const f32x4*)sp, s1 = *(const f32x4*)(sp + 4);
            raw[i] = (u32x4){pk2(s0[0], s0[1]), pk2(s0[2], s0[3]), pk2(s1[0], s1[1]), pk2(s1[2], s1[3])}; }
        else raw[i] = (u32x4){0u, 0u, 0u, 0u};
    }
}
__device__ __forceinline__ void conv_eval(const u32x4 (&raw)[4], int cc0, const float* cwl, float* o) {
    const f32x4 b0 = *(const f32x4*)(cwl + 4096 + cc0), b1 = *(const f32x4*)(cwl + 4096 + cc0 + 4);
    float acc[8] = {b0[0], b0[1], b0[2], b0[3], b1[0], b1[1], b1[2], b1[3]};
#pragma unroll
    for (int i = 0; i < 4; ++i) {
        float xv[8]; unpack8(raw[i], xv);
        const f32x4 w0 = *(const f32x4*)(cwl + i * 1024 + cc0), w1 = *(const f32x4*)(cwl + i * 1024 + cc0 + 4);
        acc[0] += w0[0] * xv[0]; acc[1] += w0[1] * xv[1]; acc[2] += w0[2] * xv[2]; acc[3] += w0[3] * xv[3];
        acc[4] += w1[0] * xv[4]; acc[5] += w1[1] * xv[5]; acc[6] += w1[2] * xv[6]; acc[7] += w1[3] * xv[7];
    }
#pragma unroll
    for (int j = 0; j < 8; ++j) o[j] = siluf(acc[j]);
}
constexpr int K3_OFF = 147456;
constexpr int K1_OFF = MISC_OFF + 128;
constexpr int CWL_OFF = 143104;

__device__ __forceinline__ void r1_ssd_grp(const Args& a, int l, int gitem, float* lds) {
    const int tid = opaque_tid(), lane = tid & 63, w = tid >> 6, c = lane & 15, q = lane >> 4;
    ItemG it; const int gr = gitem & 1; const int bn = gitem >> 1;
    if (bn < PB * NCH) { it.g = 0; it.n = bn % NCH; it.b = bn / NCH; it.L = PL; it.row0 = it.b * PL; }
    else { it.g = 1; it.b = bn - PB * NCH; it.n = 0; it.L = SL; it.row0 = PT + it.b * SL; }
    it.h = 0; it.t0 = it.n * 64; it.nv = min(64, it.L - it.t0);
    const int item0 = it.g ? NSSD_P + it.b * 8 + gr * 4 : (it.b * NCH + it.n) * 8 + gr * 4;
    unsigned char* lb = (unsigned char*)lds;
    float* dtv4 = (float*)lb; float* cum4 = dtv4 + 256;
    bf16* XT4 = (bf16*)(lb + 2048); bf16* BT = XT4 + 256 * 72;
    const float* cwl = (const float*)(lb + CWL_OFF);
    const int t = tid >> 3, j8 = tid & 7;
    const int nks = (it.nv + 31) >> 5;
    bf16* XC = (bf16*)(a.ws + WS_XC) + (size_t)(it.row0 + it.t0 + t) * 1024;
    if (tid < 256) { const int h4 = tid >> 6, tq = tid & 63; const bf16* P = (const bf16*)(a.ws + WS_PROJ);
        dtv4[tid] = (tq < it.nv) ? softplusf(bf2f(P[(size_t)(it.row0 + it.t0 + tq) * NIN + CDT + gr * 4 + h4]) + a.in[I_DTB][l * 8 + gr * 4 + h4]) : 0.f; }
    float xv[4][8];
    {
        const int cb0 = 512 + gr * 128 + j8 * 16, cc0 = 768 + gr * 128 + j8 * 16;
        float bv[16];
        if (t < it.nv) {
            u32x4 raw[4][4], rawx[4];
            conv_taps(a, l, it, it.t0 + t, cb0, raw[0]); conv_taps(a, l, it, it.t0 + t, cb0 + 8, raw[1]); conv_taps(a, l, it, it.t0 + t, cc0, raw[2]); conv_taps(a, l, it, it.t0 + t, cc0 + 8, raw[3]);
            __builtin_amdgcn_sched_barrier(0);
            float cv[16];
            conv_taps(a, l, it, it.t0 + t, (gr * 4 + 0) * 64 + j8 * 8, rawx);
            conv_eval(raw[0], cb0, cwl, bv);
            __builtin_amdgcn_sched_barrier(0);
            conv_taps(a, l, it, it.t0 + t, (gr * 4 + 1) * 64 + j8 * 8, raw[0]);
            conv_eval(raw[1], cb0 + 8, cwl, bv + 8);
            *(u32x4*)(XC + cb0) = pack8(bv); *(u32x4*)(XC + cb0 + 8) = pack8(bv + 8);
            __builtin_amdgcn_sched_barrier(0);
            conv_taps(a, l, it, it.t0 + t, (gr * 4 + 2) * 64 + j8 * 8, raw[1]);
            conv_eval(raw[2], cc0, cwl, cv);
            __builtin_amdgcn_sched_barrier(0);
            conv_taps(a, l, it, it.t0 + t, (gr * 4 + 3) * 64 + j8 * 8, raw[2]);
            conv_eval(raw[3], cc0 + 8, cwl, cv + 8);
            *(u32x4*)(XC + cc0) = pack8(cv); *(u32x4*)(XC + cc0 + 8) = pack8(cv + 8);
            __builtin_amdgcn_sched_barrier(0);
            conv_eval(rawx, (gr * 4 + 0) * 64 + j8 * 8, cwl, xv[0]); *(u32x4*)(XC + (gr * 4 + 0) * 64 + j8 * 8) = pack8(xv[0]);
            conv_eval(raw[0], (gr * 4 + 1) * 64 + j8 * 8, cwl, xv[1]); *(u32x4*)(XC + (gr * 4 + 1) * 64 + j8 * 8) = pack8(xv[1]);
            conv_eval(raw[1], (gr * 4 + 2) * 64 + j8 * 8, cwl, xv[2]); *(u32x4*)(XC + (gr * 4 + 2) * 64 + j8 * 8) = pack8(xv[2]);
            conv_eval(raw[2], (gr * 4 + 3) * 64 + j8 * 8, cwl, xv[3]); *(u32x4*)(XC + (gr * 4 + 3) * 64 + j8 * 8) = pack8(xv[3]);
        } else {
#pragma unroll
            for (int i = 0; i < 16; ++i) bv[i] = 0.f;
#pragma unroll
            for (int h4 = 0; h4 < 4; ++h4)
#pragma unroll
                for (int i = 0; i < 8; ++i) xv[h4][i] = 0.f; }
#pragma unroll
        for (int i = 0; i < 16; ++i) BT[tsw(j8 * 16 + i, t)] = (bf16)f2bf(bv[i]);
    }
    __builtin_amdgcn_sched_barrier(0);
    __syncthreads();
    if (w < 4) { const float aa = ((const float*)(lb + K1_OFF))[gr * 4 + w]; cum4[w * 64 + lane] = wave_scan_incl(dtv4[w * 64 + lane] * aa, lane); }
    __syncthreads();
#pragma unroll
    for (int h4 = 0; h4 < 4; ++h4) { const float sc = __expf(cum4[h4 * 64 + 63] - cum4[h4 * 64 + t]) * dtv4[h4 * 64 + t];
#pragma unroll
        for (int i = 0; i < 8; ++i) XT4[tsw(h4 * 64 + j8 * 8 + i, t)] = (bf16)f2bf(xv[h4][i] * sc); }
    __syncthreads();
    bf16x8 bfr[2];
#pragma unroll
    for (int ks = 0; ks < 2; ++ks) bfr[ks] = *(const bf16x8*)(BT + (16 * w + c) * 72 + fsw(w, ks, q));
#pragma unroll
    for (int h4 = 0; h4 < 4; ++h4) {
        bf16* SS = (bf16*)(a.ws + WS_SS) + (size_t)(item0 + h4) * 8192;
#pragma unroll
        for (int pt = 0; pt < 4; ++pt) {
            f32x4 acc = (f32x4){0.f, 0.f, 0.f, 0.f};
#pragma unroll
            for (int ks = 0; ks < 2; ++ks) if (ks < nks) acc = mfma16(bfr[ks], *(const bf16x8*)(XT4 + (h4 * 64 + 16 * pt + c) * 72 + fsw(4 * h4 + pt, ks, q)), acc);
            *(u32x2*)(SS + (16 * pt + c) * 128 + 16 * w + 4 * q) = (u32x2){pk2(acc[0], acc[1]), pk2(acc[2], acc[3])};
        }
    }
    if (tid < 4) ((float*)(a.ws + WS_DS))[item0 + tid] = __expf(cum4[tid * 64 + 63]);
}

__device__ __forceinline__ int q_next(unsigned* ctr, volatile unsigned* slot) {
    if (threadIdx.x == 0) *slot = __hip_atomic_fetch_add(ctr, 1u, __ATOMIC_RELAXED, __HIP_MEMORY_SCOPE_AGENT);
    __syncthreads();
    const int v = (int)*slot;
    __syncthreads();
    return v;
}
constexpr int R1_NB = 1;
__device__ __forceinline__ void r1_stage(const Args& a, int l, float* lds) {
    __syncthreads();
    float* cwl = (float*)((unsigned char*)lds + CWL_OFF); const int tid = opaque_tid();
    for (int i = tid; i < 4096; i += NTHR) cwl[i] = a.in[I_CONVW][(size_t)l * 4096 + i];
    for (int i = tid; i < 1024; i += NTHR) cwl[4096 + i] = a.in[I_CONVB][l * 1024 + i];
    if (tid < 8) ((float*)((unsigned char*)lds + K1_OFF))[tid] = -__expf(a.in[I_ALOG][l * 8 + tid]);
}
__device__ __forceinline__ void phase_r1(const Args& a, int l, float* lds, int rep) {
    static_assert(NSSD % R1_NB == 0 && NGLA % R1_NB == 0, "batches do not straddle kinds");
    unsigned* ctr = (unsigned*)(a.ws + WS_CTL) + CW_Q + ((l * 8 + 1) * 4 + rep) * 64;
    volatile unsigned* slot = (volatile unsigned*)((unsigned char*)lds + MISC_OFF) + 16;
    if (a.ph_hi - a.ph_lo == 1) { r1_stage(a, l, lds); __syncthreads(); }
    constexpr int NSG = (PB * NCH + SB) * 2;
    for (int u = blockIdx.x; u < NSG + NGLA / R1_NB; ) {
        unsigned nxt = 0u;
        if (threadIdx.x == 0) nxt = gridDim.x + __hip_atomic_fetch_add(ctr, 1u, __ATOMIC_RELAXED, __HIP_MEMORY_SCOPE_AGENT);
        if (u < NSG) r1_ssd_grp(a, l, u, lds); else r1_gla_b<R1_NB>(a, l, (u - NSG) * R1_NB, lds);
        if (threadIdx.x == 0) *slot = nxt;
        __syncthreads();
        u = (int)*slot;
    }
    const bf16* P = (const bf16*)(a.ws + WS_PROJ);
    const int gt = blockIdx.x * NTHR + opaque_tid(), GT = gridDim.x * NTHR;
    for (int i = gt; i < (PB + SB) * 3 * 128; i += GT) {
        const int c8 = (i & 127) * 8, j = (i >> 7) % 3, b = i / 384;
        const bf16* src; float* dst;
        if (b < PB) { src = P + (size_t)(b * PL + PL - 3 + j) * NIN + CX + c8; dst = a.out + O_CP + ((size_t)(l * PB + b) * 3 + j) * 1024 + c8; }
        else { const int sb = b - PB; src = P + (size_t)(PT + sb * SL + SL - 3 + j) * NIN + CX + c8; dst = a.out + O_CS + ((size_t)(l * SB + sb) * 3 + j) * 1024 + c8; }
        float f[8]; unpack8(*(const u32x4*)src, f);
        *(f32x4*)dst = (f32x4){f[0], f[1], f[2], f[3]}; *(f32x4*)(dst + 4) = (f32x4){f[4], f[5], f[6], f[7]};
    }
}

__device__ __forceinline__ void phase_r2(const Args& a, int l) {
    const size_t gt = (size_t)blockIdx.x * NTHR + opaque_tid(), GT = (size_t)gridDim.x * NTHR;
    constexpr size_t N0 = (size_t)PB * 4 * 2048, N1 = (size_t)PB * 8 * 2048, N2 = (size_t)SB * 4 * 2048, N3 = (size_t)SB * 8 * 2048;
    bf16* SG = (bf16*)(a.ws + WS_SG); float* DG = (float*)(a.ws + WS_DG); bf16* SS = (bf16*)(a.ws + WS_SS); float* DS = (float*)(a.ws + WS_DS);
    typedef float f32x2 __attribute__((ext_vector_type(2)));
    for (size_t i = gt; i < 2 * (N0 + N1); i += GT) {
        bf16* p; const float* dp; size_t pstride, dstride; float* outp;
        if (i < 2 * N0) {
            const int e2 = (int)(i & 4095), bh = (int)(i >> 12), h = bh & 3, b = bh >> 2, d = e2 >> 6;
            const size_t item0 = (size_t)(b * NCH) * 4 + h;
            p = SG + item0 * 8192 + e2 * 2; pstride = 4 * 8192; dp = DG + item0 * 64 + d; dstride = 4 * 64;
            outp = a.out + O_GP + ((size_t)(l * PB + b) * 4 + h) * 8192 + e2 * 2;
        } else {
            const size_t j = i - 2 * N0; const int e2 = (int)(j & 4095), bh = (int)(j >> 12), hd = bh & 7, b = bh >> 3;
            const size_t item0 = (size_t)(b * NCH) * 8 + hd;
            p = SS + item0 * 8192 + e2 * 2; pstride = 8 * 8192; dp = DS + item0; dstride = 8;
            outp = a.out + O_SP + ((size_t)(l * PB + b) * 8 + hd) * 8192 + e2 * 2;
        }
        f32x2 s = (f32x2){0.f, 0.f};
        {
            unsigned loc[NCH]; float dec[NCH];
#pragma unroll
            for (int k = 0; k < NCH; ++k) { loc[k] = *(const unsigned*)(p + (size_t)k * pstride); dec[k] = dp[(size_t)k * dstride]; }
#pragma unroll
            for (int k = 0; k < NCH; ++k) { *(unsigned*)(p + (size_t)k * pstride) = pk2(s[0], s[1]); s = s * dec[k] + (f32x2){__uint_as_float(loc[k] << 16), __uint_as_float(loc[k] & 0xffff0000u)}; }
        }
        *(f32x2*)outp = s;
    }
    for (size_t i0 = gt; i0 < N2 + N3; i0 += 4 * GT) {
        f32x4 s0[4]; u32x2 loc[4]; float dec[4]; float* outp[4];
#pragma unroll
        for (int k = 0; k < 4; ++k) { const size_t i = i0 + (size_t)k * GT; outp[k] = nullptr;
            if (i < N2) {
                const int e4 = (int)(i & 2047), bh = (int)(i >> 11), d = e4 >> 5; const size_t item = NGLA_P + bh;
                s0[k] = *(const f32x4*)(a.in[I_SGLA] + ((size_t)l * SB * 4 + bh) * 8192 + e4 * 4);
                loc[k] = *(const u32x2*)(SG + item * 8192 + e4 * 4); dec[k] = DG[item * 64 + d];
                outp[k] = a.out + O_GS + ((size_t)l * SB * 4 + bh) * 8192 + e4 * 4;
            } else if (i < N2 + N3) {
                const size_t j = i - N2; const int e4 = (int)(j & 2047), bh = (int)(j >> 11); const size_t item = NSSD_P + bh;
                s0[k] = *(const f32x4*)(a.in[I_SSSM] + ((size_t)l * SB * 8 + bh) * 8192 + e4 * 4);
                loc[k] = *(const u32x2*)(SS + item * 8192 + e4 * 4); dec[k] = DS[item];
                outp[k] = a.out + O_SS + ((size_t)l * SB * 8 + bh) * 8192 + e4 * 4;
            } }
#pragma unroll
        for (int k = 0; k < 4; ++k) if (outp[k]) *(f32x4*)outp[k] = s0[k] * dec[k] + (f32x4){__uint_as_float(loc[k].x << 16), __uint_as_float(loc[k].x & 0xffff0000u), __uint_as_float(loc[k].y << 16), __uint_as_float(loc[k].y & 0xffff0000u)};
    }
}

template <int NB>
__device__ __forceinline__ void r3_gla_b(const Args& a, int l, int item0, float* lds) {
    const int tid = opaque_tid(), lane = tid & 63, w = tid >> 6, c = lane & 15, q = lane >> 4;
    constexpr int SZ = 64512;
    const int t = tid >> 3, j8 = tid & 7;
    ItemG it[NB]; u32x4 rg[NB][2];
#pragma unroll
    for (int u = 0; u < NB; ++u) {
        it[u] = decode_gla(item0 + u);
        bf16* QS = (bf16*)((unsigned char*)lds + u * SZ); bf16* KS = QS + 64 * 72; bf16* VT = KS + 2 * 64 * 72; bf16* ST = VT + 128 * 72;
        const bf16* P = (const bf16*)(a.ws + WS_PROJ) + (size_t)(it[u].row0 + it[u].t0) * NIN;
        const u32x4 z4 = (u32x4){0u, 0u, 0u, 0u};
        u32x4 rk = z4, rq = z4, rv0 = z4, rv1 = z4; rg[u][0] = z4; rg[u][1] = z4;
        if (t < it[u].nv) { rk = *(const u32x4*)(P + (size_t)t * NIN + CK + it[u].h * 64 + j8 * 8); rq = *(const u32x4*)(P + (size_t)t * NIN + CQ + it[u].h * 64 + j8 * 8);
            rv0 = *(const u32x4*)(P + (size_t)t * NIN + CV + it[u].h * 128 + j8 * 16); rv1 = *(const u32x4*)(P + (size_t)t * NIN + CV + it[u].h * 128 + j8 * 16 + 8);
            rg[u][0] = *(const u32x4*)(P + (size_t)t * NIN + CG + it[u].h * 128 + j8 * 16); rg[u][1] = *(const u32x4*)(P + (size_t)t * NIN + CG + it[u].h * 128 + j8 * 16 + 8); }
        const float* BCg = (const float*)(a.ws + WS_BC) + (size_t)(item0 + u) * 4096 + t * 64 + j8 * 8;
        const f32x4 b0 = *(const f32x4*)BCg, b1 = *(const f32x4*)(BCg + 4);
        u32x4 sw0, sw1;
        if (it[u].g) { const float* sp = a.in[I_SGLA] + ((size_t)(l * SB + it[u].b) * 4 + it[u].h) * 8192 + t * 128 + j8 * 16;
            const f32x4 s0 = *(const f32x4*)sp, s1 = *(const f32x4*)(sp + 4), s2 = *(const f32x4*)(sp + 8), s3 = *(const f32x4*)(sp + 12);
            sw0 = (u32x4){pk2(s0[0], s0[1]), pk2(s0[2], s0[3]), pk2(s1[0], s1[1]), pk2(s1[2], s1[3])}; sw1 = (u32x4){pk2(s2[0], s2[1]), pk2(s2[2], s2[3]), pk2(s3[0], s3[1]), pk2(s3[2], s3[3])};
        } else { const bf16* sp = (const bf16*)(a.ws + WS_SG) + (size_t)(item0 + u) * 8192 + t * 128 + j8 * 16; sw0 = *(const u32x4*)sp; sw1 = *(const u32x4*)(sp + 8); }
        {
            const float bb[8] = {b0[0], b0[1], b0[2], b0[3], b1[0], b1[1], b1[2], b1[3]};
            float kf[8], qf[8]; unpack8(rk, kf); unpack8(rq, qf);
#pragma unroll
            for (int i = 0; i < 8; ++i) { qf[i] *= __expf(bb[i]); kf[i] *= __expf(-bb[i]); }
            *(u32x4*)(QS + t * 72 + j8 * 8) = pack8(qf); *(u32x4*)(KS + t * 72 + j8 * 8) = pack8(kf);
        }
        {
            const unsigned wv[8] = {rv0.x, rv0.y, rv0.z, rv0.w, rv1.x, rv1.y, rv1.z, rv1.w};
            const unsigned sv[8] = {sw0.x, sw0.y, sw0.z, sw0.w, sw1.x, sw1.y, sw1.z, sw1.w};
#pragma unroll
            for (int i = 0; i < 16; ++i) { VT[tsw(j8 * 16 + i, t)] = (bf16)((i & 1) ? (wv[i >> 1] >> 16) : (wv[i >> 1] & 0xffffu)); ST[tsw(j8 * 16 + i, t)] = (bf16)((i & 1) ? (sv[i >> 1] >> 16) : (sv[i >> 1] & 0xffffu)); }
        }
    }
    __syncthreads();
#pragma unroll
    for (int u = 0; u < NB; ++u) {
        const bf16* QS = (const bf16*)((unsigned char*)lds + u * SZ); const bf16* KS = QS + 64 * 72; bf16* AT = (bf16*)(KS + 64 * 72);
        const int tt = w >> 1, ntt = (it[u].nv + 15) >> 4;
#pragma unroll
        for (int v = 0; v < 2; ++v) { const int st = 2 * (w & 1) + v;
            f32x4 acc = (f32x4){0.f, 0.f, 0.f, 0.f};
            if (st <= tt && tt < ntt) {
#pragma unroll
                for (int ks = 0; ks < 2; ++ks) { const bf16x8 af = *(const bf16x8*)(QS + (16 * tt + c) * 72 + 32 * ks + 8 * q); const bf16x8 bfr = *(const bf16x8*)(KS + (16 * st + c) * 72 + 32 * ks + 8 * q); acc = mfma16(af, bfr, acc); } }
#pragma unroll
            for (int r = 0; r < 4; ++r) { const int tq = 16 * tt + 4 * q + r, s = 16 * st + c; AT[tq * 72 + s] = (s <= tq) ? (bf16)f2bf(acc[r]) : (bf16)0; }
        }
    }
    __syncthreads();
    f32x4 oacc[NB][4];
#pragma unroll
    for (int u = 0; u < NB; ++u) {
        const bf16* QS = (const bf16*)((unsigned char*)lds + u * SZ); const bf16* AT = QS + 2 * 64 * 72; const bf16* VT = AT + 64 * 72; const bf16* ST = VT + 128 * 72;
        const int ntt = (it[u].nv + 15) >> 4, nks = (it[u].nv + 31) >> 5;
        bf16x8 vf[2], sf[2];
#pragma unroll
        for (int ks = 0; ks < 2; ++ks) { vf[ks] = *(const bf16x8*)(VT + (16 * w + c) * 72 + fsw(w, ks, q)); sf[ks] = *(const bf16x8*)(ST + (16 * w + c) * 72 + fsw(w, ks, q)); }
#pragma unroll
        for (int tt = 0; tt < 4; ++tt) { oacc[u][tt] = (f32x4){0.f, 0.f, 0.f, 0.f};
            if (tt < ntt) {
#pragma unroll
                for (int ks = 0; ks < 2; ++ks) if (ks < nks) oacc[u][tt] = mfma16(*(const bf16x8*)(AT + (16 * tt + c) * 72 + 32 * ks + 8 * q), vf[ks], oacc[u][tt]);
#pragma unroll
                for (int ks = 0; ks < 2; ++ks) oacc[u][tt] = mfma16(*(const bf16x8*)(QS + (16 * tt + c) * 72 + 32 * ks + 8 * q), sf[ks], oacc[u][tt]);
            } }
    }
    __syncthreads();
#pragma unroll
    for (int u = 0; u < NB; ++u) {
        bf16* O = (bf16*)((unsigned char*)lds + u * SZ);
#pragma unroll
        for (int tt = 0; tt < 4; ++tt)
#pragma unroll
            for (int r = 0; r < 4; ++r) O[(16 * tt + 4 * q + r) * 136 + 16 * w + c] = (bf16)f2bf(oacc[u][tt][r]);
    }
    __syncthreads();
#pragma unroll
    for (int u = 0; u < NB; ++u) {
        const bf16* O = (const bf16*)((unsigned char*)lds + u * SZ);
        float of[16], gf[16];
        unpack8(*(const u32x4*)(O + t * 136 + j8 * 16), of); unpack8(*(const u32x4*)(O + t * 136 + j8 * 16 + 8), of + 8);
        unpack8(rg[u][0], gf); unpack8(rg[u][1], gf + 8);
        float ss = 0.f;
#pragma unroll
        for (int i = 0; i < 16; ++i) ss += of[i] * of[i];
        ss += __shfl_xor(ss, 1); ss += __shfl_xor(ss, 2); ss += __shfl_xor(ss, 4);
        const float rs = rsqrtf(ss * (1.0f / 128.0f) + EPS);
        if (t < it[u].nv) {
            const float* nw = (const float*)((const unsigned char*)lds + K3_OFF) + 32 + j8 * 16;
            const f32x4 n0 = *(const f32x4*)nw, n1 = *(const f32x4*)(nw + 4), n2 = *(const f32x4*)(nw + 8), n3 = *(const f32x4*)(nw + 12);
            const float nf[16] = {n0[0], n0[1], n0[2], n0[3], n1[0], n1[1], n1[2], n1[3], n2[0], n2[1], n2[2], n2[3], n3[0], n3[1], n3[2], n3[3]};
            float ov[16];
#pragma unroll
            for (int i = 0; i < 16; ++i) ov[i] = of[i] * rs * nf[i] * siluf(gf[i]);
            bf16* MX = (bf16*)(a.ws + WS_MIX) + (size_t)(it[u].row0 + it[u].t0 + t) * DM + it[u].h * 128 + j8 * 16;
            *(u32x4*)MX = pack8(ov); *(u32x4*)(MX + 8) = pack8(ov + 8);
        }
    }
}

__device__ __forceinline__ void r3_ssd(const Args& a, int l, int item, float* lds) {
    const int tid = opaque_tid(), lane = tid & 63, w = tid >> 6, c = lane & 15, q = lane >> 4;
    ItemG it;
    if (item < PB * NCH) { it.g = 0; it.n = item % NCH; it.b = item / NCH; it.L = PL; it.row0 = it.b * PL; }
    else { it.g = 1; it.b = item - PB * NCH; it.n = 0; it.L = SL; it.row0 = PT + it.b * SL; }
    it.h = 0; it.t0 = it.n * 64; it.nv = min(64, it.L - it.t0);
    unsigned char* lb = (unsigned char*)lds;
    float* dtv4 = (float*)lb; float* cum4 = dtv4 + 256;
    bf16* CS = (bf16*)(lb + 4096); bf16* BSm = (bf16*)(lb + 21504);
    bf16* XT4 = (bf16*)(lb + 38912);
    bf16* MM4 = (bf16*)(lb + 75776);
    bf16* Y0 = (bf16*)(lb + 112640);
    const int ntt = (it.nv + 15) >> 4, nks = (it.nv + 31) >> 5;
    const bf16* P = (const bf16*)(a.ws + WS_PROJ) + (size_t)(it.row0 + it.t0) * NIN;
    const int ts = tid >> 3, j8 = tid & 7;
    u32x4 zr[8];
    for (int gr = 0; gr < 2; ++gr) {
        const int hh = w >> 1, hd = gr * 4 + hh;
        if (tid < 256) { const int h4 = tid >> 6, t = tid & 63;
            dtv4[tid] = (t < it.nv) ? softplusf(bf2f(P[(size_t)t * NIN + CDT + gr * 4 + h4]) + a.in[I_DTB][l * 8 + gr * 4 + h4]) : 0.f; }
        bf16x8 hfr[2][4];
        if (it.g) { const float* Hsrc = a.in[I_SSSM] + ((size_t)(l * SB + it.b) * 8 + hd) * 8192;
#pragma unroll
            for (int u = 0; u < 2; ++u)
#pragma unroll
                for (int ks = 0; ks < 4; ++ks) { const float* hp = Hsrc + (16 * (2 * (w & 1) + u) + c) * 128 + 32 * ks + 8 * q; const f32x4 h0 = *(const f32x4*)hp, h1 = *(const f32x4*)(hp + 4);
                    const u32x4 pk = (u32x4){pk2(h0[0], h0[1]), pk2(h0[2], h0[3]), pk2(h1[0], h1[1]), pk2(h1[2], h1[3])}; hfr[u][ks] = __builtin_bit_cast(bf16x8, pk); }
        } else { const bf16* Hsrc = (const bf16*)(a.ws + WS_SS) + ((size_t)(it.b * NCH + it.n) * 8 + hd) * 8192;
#pragma unroll
            for (int u = 0; u < 2; ++u)
#pragma unroll
                for (int ks = 0; ks < 4; ++ks) hfr[u][ks] = *(const bf16x8*)(Hsrc + (16 * (2 * (w & 1) + u) + c) * 128 + 32 * ks + 8 * q);
        }
        {
            const bf16* XCr = (const bf16*)(a.ws + WS_XC) + (size_t)(it.row0 + it.t0 + ts) * 1024;
            u32x4 rc[2], rb[2], rx[4];
            const u32x4 z4 = (u32x4){0u, 0u, 0u, 0u};
#pragma unroll
            for (int hf = 0; hf < 2; ++hf) { rc[hf] = ts < it.nv ? *(const u32x4*)(XCr + 768 + gr * 128 + j8 * 16 + 8 * hf) : z4; rb[hf] = ts < it.nv ? *(const u32x4*)(XCr + 512 + gr * 128 + j8 * 16 + 8 * hf) : z4; }
#pragma unroll
            for (int h4 = 0; h4 < 4; ++h4) rx[h4] = ts < it.nv ? *(const u32x4*)(XCr + (gr * 4 + h4) * 64 + j8 * 8) : z4;
#pragma unroll
            for (int hf = 0; hf < 2; ++hf) { *(u32x4*)(CS + ts * 136 + j8 * 16 + 8 * hf) = rc[hf]; *(u32x4*)(BSm + ts * 136 + j8 * 16 + 8 * hf) = rb[hf]; }
#pragma unroll
            for (int h4 = 0; h4 < 4; ++h4) { const unsigned wv[4] = {rx[h4].x, rx[h4].y, rx[h4].z, rx[h4].w};
#pragma unroll
                for (int i = 0; i < 8; ++i) XT4[tsw(h4 * 64 + j8 * 8 + i, ts)] = (bf16)((i & 1) ? (wv[i >> 1] >> 16) : (wv[i >> 1] & 0xffffu)); }
        }
        __syncthreads();
        if (w < 4) { const float aa = ((const float*)(lb + K3_OFF))[gr * 4 + w]; cum4[w * 64 + lane] = wave_scan_incl(dtv4[w * 64 + lane] * aa, lane); }
        f32x4 cbacc[2]; const int ttc = w >> 1;
#pragma unroll
        for (int u = 0; u < 2; ++u) { const int st = 2 * (w & 1) + u; cbacc[u] = (f32x4){0.f, 0.f, 0.f, 0.f};
            if (st <= ttc && ttc < ntt) {
#pragma unroll
                for (int ks = 0; ks < 4; ++ks) cbacc[u] = mfma16(*(const bf16x8*)(CS + (16 * ttc + c) * 136 + 32 * ks + 8 * q), *(const bf16x8*)(BSm + (16 * st + c) * 136 + 32 * ks + 8 * q), cbacc[u]); } }
        __syncthreads();
#pragma unroll
        for (int h4 = 0; h4 < 4; ++h4)
#pragma unroll
            for (int u = 0; u < 2; ++u) { const int st = 2 * (w & 1) + u;
#pragma unroll
                for (int r = 0; r < 4; ++r) { const int t = 16 * ttc + 4 * q + r, s = 16 * st + c;
                    const float m = (s <= t) ? cbacc[u][r] * __expf(cum4[h4 * 64 + t] - cum4[h4 * 64 + s]) * dtv4[h4 * 64 + s] : 0.f;
                    MM4[h4 * 4608 + t * 72 + s] = (bf16)f2bf(m); } }
        __syncthreads();
        if (gr == 1) {
#pragma unroll
            for (int i = 0; i < 8; ++i) zr[i] = (ts < it.nv) ? *(const u32x4*)(P + (size_t)ts * NIN + CZ + (j8 + 8 * i) * 8) : (u32x4){0u, 0u, 0u, 0u}; }
        f32x4 yv[2][4];
        {
            const float dsk = ((const float*)(lb + K3_OFF))[8 + hd];
#pragma unroll
            for (int u = 0; u < 2; ++u) { const int pt = 2 * (w & 1) + u;
#pragma unroll
                for (int tt = 0; tt < 4; ++tt) { yv[u][tt] = (f32x4){0.f, 0.f, 0.f, 0.f};
                    if (tt < ntt) {
                        f32x4 ia = (f32x4){0.f, 0.f, 0.f, 0.f}, ie = ia;
#pragma unroll
                        for (int ks = 0; ks < 2; ++ks) if (ks < nks) ia = mfma16(*(const bf16x8*)(MM4 + hh * 4608 + (16 * tt + c) * 72 + 32 * ks + 8 * q), *(const bf16x8*)(XT4 + (hh * 64 + 16 * pt + c) * 72 + fsw(4 * hh + pt, ks, q)), ia);
#pragma unroll
                        for (int ks = 0; ks < 4; ++ks) ie = mfma16(*(const bf16x8*)(CS + (16 * tt + c) * 136 + 32 * ks + 8 * q), hfr[u][ks], ie);
#pragma unroll
                        for (int r = 0; r < 4; ++r) { const int t = 16 * tt + 4 * q + r, p = 16 * pt + c;
                            yv[u][tt][r] = ia[r] + __expf(cum4[hh * 64 + t]) * ie[r] + dsk * bf2f(XT4[tsw(hh * 64 + p, t)]); }
                    } } }
        }
        __syncthreads();
        {
            bf16* Yg = gr ? MM4 : Y0;
#pragma unroll
            for (int u = 0; u < 2; ++u)
#pragma unroll
                for (int tt = 0; tt < 4; ++tt)
#pragma unroll
                    for (int r = 0; r < 4; ++r) { const int t = 16 * tt + 4 * q + r, p = 16 * (2 * (w & 1) + u) + c;
                        if (t < it.nv) Yg[t * 264 + hh * 64 + p] = (bf16)f2bf(yv[u][tt][r]); }
        }
    }
    __syncthreads();
    {
        float yg[64]; float ss = 0.f;
        const bool ok = ts < it.nv;
#pragma unroll
        for (int i = 0; i < 8; ++i) { const int cc = (j8 + 8 * i) * 8;
            float y8[8], z8[8];
            if (ok) { unpack8(*(const u32x4*)(((cc >> 8) ? MM4 : Y0) + ts * 264 + (cc & 255)), y8); unpack8(zr[i], z8); }
            else {
#pragma unroll
                for (int j = 0; j < 8; ++j) { y8[j] = 0.f; z8[j] = 0.f; } }
#pragma unroll
            for (int j = 0; j < 8; ++j) { const float v = y8[j] * siluf(z8[j]); yg[8 * i + j] = v; ss += v * v; } }
        ss += __shfl_xor(ss, 1); ss += __shfl_xor(ss, 2); ss += __shfl_xor(ss, 4);
        const float rs = rsqrtf(ss * (1.0f / 512.0f) + EPS);
        if (ok) {
            bf16* MX = (bf16*)(a.ws + WS_MIX) + (size_t)(it.row0 + it.t0 + ts) * DM + 512;
#pragma unroll
            for (int i = 0; i < 8; ++i) { const int cc = (j8 + 8 * i) * 8;
                const float* nw = (const float*)(lb + K3_OFF) + 160 + cc; const f32x4 n0 = *(const f32x4*)nw, n1 = *(const f32x4*)(nw + 4);
                float f[8];
                f[0] = yg[8 * i] * rs * n0[0]; f[1] = yg[8 * i + 1] * rs * n0[1]; f[2] = yg[8 * i + 2] * rs * n0[2]; f[3] = yg[8 * i + 3] * rs * n0[3];
                f[4] = yg[8 * i + 4] * rs * n1[0]; f[5] = yg[8 * i + 5] * rs * n1[1]; f[6] = yg[8 * i + 6] * rs * n1[2]; f[7] = yg[8 * i + 7] * rs * n1[3];
                *(u32x4*)(MX + cc) = pack8(f); }
        }
    }
}

constexpr int R3_NB = 1;
__device__ __forceinline__ void r3_stage(const Args& a, int l, float* lds) {
    __syncthreads();
    float* k3 = (float*)((unsigned char*)lds + K3_OFF); const int tid = opaque_tid();
    if (tid < 8) { k3[tid] = -__expf(a.in[I_ALOG][l * 8 + tid]); k3[8 + tid] = a.in[I_DSKIP][l * 8 + tid]; }
    if (tid < 128) k3[32 + tid] = a.in[I_GLANW][l * 128 + tid];
    k3[160 + tid] = a.in[I_SSDNW][l * 512 + tid];
}
__device__ __forceinline__ void phase_r3(const Args& a, int l, float* lds, int rep) {
    constexpr int NS3 = PB * NCH + SB;
    static_assert(NGLA_P % R3_NB == 0 && NGLA % R3_NB == 0, "batches");
    unsigned* ctr = (unsigned*)(a.ws + WS_CTL) + CW_Q + ((l * 8 + 3) * 4 + rep) * 64;
    volatile unsigned* slot = (volatile unsigned*)((unsigned char*)lds + MISC_OFF) + 16;
    if (a.ph_hi - a.ph_lo == 1) { r3_stage(a, l, lds); __syncthreads(); }
    for (int u = blockIdx.x; u < NS3 + NGLA / R3_NB; ) {
        unsigned nxt = 0u;
        if (threadIdx.x == 0) nxt = gridDim.x + __hip_atomic_fetch_add(ctr, 1u, __ATOMIC_RELAXED, __HIP_MEMORY_SCOPE_AGENT);
        if (u < NS3) r3_ssd(a, l, u, lds); else r3_gla_b<R3_NB>(a, l, (u - NS3) * R3_NB, lds);
        if (threadIdx.x == 0) *slot = nxt;
        __syncthreads();
        u = (int)*slot;
    }
}

constexpr int UT_NT = 1096, UT_NE = 1024, UT_CAP = 20;
constexpr int UT_LCAP = UT_CAP * 512;
__device__ __forceinline__ unsigned ordkey(float s) { const unsigned u = __float_as_uint(s); return (u & 0x80000000u) ? ~u : (u | 0x80000000u); }
__device__ __forceinline__ float keyval(unsigned k) { return __uint_as_float((k & 0x80000000u) ? (k & 0x7fffffffu) : ~k); }
#define CE_DESC(a, b) { const unsigned _hi = max(a, b), _lo = min(a, b); a = _hi; b = _lo; }
__device__ __forceinline__ void sort16_desc(unsigned (&v)[16]) {
#pragma unroll
    for (int k = 2; k <= 16; k <<= 1)
#pragma unroll
        for (int j = k >> 1; j > 0; j >>= 1)
#pragma unroll
            for (int i = 0; i < 16; ++i) { const int l = i ^ j; if (l > i) { if ((i & k) == 0) CE_DESC(v[i], v[l]) else CE_DESC(v[l], v[i]) } }
}
__device__ __forceinline__ void merge16_desc(unsigned (&L)[16], const unsigned (&G)[16]) {
#pragma unroll
    for (int i = 0; i < 16; ++i) L[i] = max(L[i], G[15 - i]);
#pragma unroll
    for (int j = 8; j > 0; j >>= 1)
#pragma unroll
        for (int i = 0; i < 16; ++i) { const int l = i ^ j; if (l > i) CE_DESC(L[i], L[l]) }
}
__device__ __forceinline__ void xmerge16(unsigned (&L)[16], int mask) {
    unsigned G[16];
#pragma unroll
    for (int i = 0; i < 16; ++i) {
        if (mask == 16) { const auto r = __builtin_amdgcn_permlane16_swap(L[i], L[i], false, false); L[i] = r[0]; G[i] = r[1]; }
        else { const auto r = __builtin_amdgcn_permlane32_swap(L[i], L[i], false, false); L[i] = r[0]; G[i] = r[1]; } }
    merge16_desc(L, G);
}

__device__ __forceinline__ void xquant_tokens(const Args& a, int gw, int NGW) {
    const int lane = opaque_tid() & 63;
    {
        const bf16* HB = (const bf16*)(a.ws + WS_HB); const float* SSQ2 = (const float*)(a.ws + WS_SSQ2);
        for (int g4 = gw; g4 < T / 4; g4 += NGW) {
            u32x4 xq[4];
#pragma unroll
            for (int z = 0; z < 4; ++z) { const int t = 4 * g4 + z;
                float xf[16];
                unpack8(*(const u32x4*)(HB + (size_t)t * DM + lane * 16), xf); unpack8(*(const u32x4*)(HB + (size_t)t * DM + lane * 16 + 8), xf + 8);
                float am = 0.f;
#pragma unroll
                for (int i = 0; i < 16; ++i) am = fmaxf(am, fabsf(xf[i]));
                am = wave_max_nonneg(am);
                const float sx = am > 0.f ? am * (1.0f / 127.0f) : 1.0f, xinv = 1.0f / sx;
                unsigned wv[4];
#pragma unroll
                for (int j = 0; j < 4; ++j) { const int q0 = (int)rintf(xf[4 * j] * xinv), q1 = (int)rintf(xf[4 * j + 1] * xinv), q2 = (int)rintf(xf[4 * j + 2] * xinv), q3 = (int)rintf(xf[4 * j + 3] * xinv);
                    wv[j] = (unsigned)(q0 & 255) | ((unsigned)(q1 & 255) << 8) | ((unsigned)(q2 & 255) << 16) | ((unsigned)(q3 & 255) << 24); }
                xq[z] = (u32x4){wv[0], wv[1], wv[2], wv[3]};
                if (lane == 0) { float s2 = 0.f;
#pragma unroll
                    for (int i = 0; i < 16; ++i) s2 += SSQ2[(size_t)t * 16 + i];
                    ((float*)(a.ws + WS_HS))[t] = rsqrtf(s2 * (1.0f / 1024.0f) + EPS) * sx; }
            }
            u32x4* dst = (u32x4*)(a.ws + WS_X8 + ((size_t)lane * T + 4 * g4) * 16);
            dst[0] = xq[0]; dst[1] = xq[1]; dst[2] = xq[2]; dst[3] = xq[3];
        }
    }
}

__device__ __forceinline__ void route_stage(const Args& a, int l, float* lds) {
    __syncthreads();
    bf16* KB = (bf16*)lds; const int tid = opaque_tid();
    for (int i = tid; i < 2 * 128 * 8; i += NTHR) {
        const int hf = i >> 10, j = (i >> 3) & 127, g8 = i & 7;
        const float* src = a.in[hf ? I_K2 : I_K1] + (size_t)l * 8192 + j * 64 + g8 * 8;
        const f32x4 x0 = *(const f32x4*)src, x1 = *(const f32x4*)(src + 4);
        *(u32x4*)(KB + (hf * 128 + j) * 72 + g8 * 8) = (u32x4){pk2(x0[0], x0[1]), pk2(x0[2], x0[3]), pk2(x1[0], x1[1]), pk2(x1[2], x1[3])};
    }
}
__device__ __forceinline__ void phase_route(const Args& a, int l, float* lds) {
    const int tid = opaque_tid(), lane = tid & 63, wave = tid >> 6, c = lane & 15, q = lane >> 4;
    const bf16* KB = (const bf16*)lds;
    if (a.ph_hi - a.ph_lo == 1) { route_stage(a, l, lds); __syncthreads(); }
    const bf16* Q = (const bf16*)(a.ws + WS_Q);
    int* RE = (int*)(a.ws + WS_RE); float* RG = (float*)(a.ws + WS_RG);
    constexpr int NTASK = T * 8 / 16;
    unsigned* rel = (unsigned*)((unsigned char*)lds + 36864);
    unsigned* cnt = rel + 70 * 128; unsigned* bbase = cnt + 16; unsigned* loc = cnt + 32;
    constexpr int BCAP = 1024;
    unsigned* PL = (unsigned*)(a.ws + WS_PL); unsigned* GC = (unsigned*)(a.ws + WS_CTL) + CW_GC + l * 256;
    for (int job = blockIdx.x; job < 256; job += gridDim.x) {
    const int tb = job >> 4, part = job & 15, tl_lo = 2 * ((part * (UT_NT / 2)) >> 4), tl_hi = 2 * (((part + 1) * (UT_NT / 2)) >> 4), ntok = tl_hi - tl_lo;
    const int task_lo = (tb * UT_NT + tl_lo) >> 1, task_hi = task_lo + (ntok >> 1);
    if (tid < 16) cnt[tid] = 0u;
    const int task0 = task_lo + wave, tstride = NWAVES;
    u32x4 qn[4];
    {   const int p0 = min(task0, NTASK - 1) * 16 + c; const bf16* qp = Q + (size_t)(p0 >> 3) * DM + (p0 & 7) * 128 + 8 * q;
        qn[0] = *(const u32x4*)qp; qn[1] = *(const u32x4*)(qp + 32); qn[2] = *(const u32x4*)(qp + 64); qn[3] = *(const u32x4*)(qp + 96); }
    for (int task = task0; task < task_hi; task += tstride) {
        const int p = task * 16 + c, t = p >> 3, h = p & 7;
        const u32x4 qc[4] = {qn[0], qn[1], qn[2], qn[3]};
        {   const int pn = min(task + tstride, NTASK - 1) * 16 + c; const bf16* qp = Q + (size_t)(pn >> 3) * DM + (pn & 7) * 128 + 8 * q;
            qn[0] = *(const u32x4*)qp; qn[1] = *(const u32x4*)(qp + 32); qn[2] = *(const u32x4*)(qp + 64); qn[3] = *(const u32x4*)(qp + 96); }
        unsigned l1[16], l2[16];
#pragma unroll
        for (int half = 0; half < 2; ++half) {
            const bf16x8 b0 = __builtin_bit_cast(bf16x8, qc[2 * half]), b1 = __builtin_bit_cast(bf16x8, qc[2 * half + 1]);
            unsigned g0[16], g1[16];
#pragma unroll
            for (int n = 0; n < 8; ++n) {
                f32x4 acc = (f32x4){0.f, 0.f, 0.f, 0.f};
                const bf16* kp = KB + (half * 128 + 16 * n + c) * 72 + 8 * q;
                acc = mfma16(*(const bf16x8*)kp, b0, acc);
                acc = mfma16(*(const bf16x8*)(kp + 32), b1, acc);
#pragma unroll
                for (int r = 0; r < 4; ++r) { const unsigned key = (ordkey(acc[r]) & ~0x7Fu) | (unsigned)(16 * n + 4 * q + r);
                    if (n < 4) g0[4 * n + r] = key; else g1[4 * (n - 4) + r] = key; }
                if (n & 1) __builtin_amdgcn_sched_barrier(0);
            }
            sort16_desc(g0); __builtin_amdgcn_sched_barrier(0); sort16_desc(g1); __builtin_amdgcn_sched_barrier(0); merge16_desc(g0, g1); __builtin_amdgcn_sched_barrier(0);
            xmerge16(g0, 16); __builtin_amdgcn_sched_barrier(0); xmerge16(g0, 32); __builtin_amdgcn_sched_barrier(0);
#pragma unroll
            for (int i = 0; i < 16; ++i) { if (half == 0) l1[i] = g0[i]; else l2[i] = g0[i]; }
        }
        unsigned cA[16], cB[16];
        {
            const unsigned k10 = q == 0 ? l1[0] : (q == 1 ? l1[1] : (q == 2 ? l1[2] : l1[3]));
            const float v10 = keyval(k10 & ~0x7Fu);
#pragma unroll
            for (int j = 0; j < 16; ++j) { const float sum = v10 + keyval(l2[j] & ~0x7Fu);
                cA[j] = ((q + 1) * (j + 1) <= 16) ? ((ordkey(sum) & ~0xFFu) | (unsigned)(q * 16 + j)) : 0u; }
#pragma unroll
            for (int j = 0; j < 16; ++j) cB[j] = 0u;
#pragma unroll
            for (int ii = 1; ii < 4; ++ii) {
                const unsigned k1 = q == 0 ? l1[4 * ii] : (q == 1 ? l1[4 * ii + 1] : (q == 2 ? l1[4 * ii + 2] : l1[4 * ii + 3]));
                const float v1 = keyval(k1 & ~0x7Fu); const int i = 4 * ii + q;
#pragma unroll
                for (int j = 0; j < 3; ++j) if ((4 * ii + 1) * (j + 1) <= 16) {
                    const float sum = v1 + keyval(l2[j] & ~0x7Fu);
                    cB[(ii == 1 ? 0 : (ii == 2 ? 3 : 4)) + j] = ((i + 1) * (j + 1) <= 16) ? ((ordkey(sum) & ~0xFFu) | (unsigned)(i * 16 + j)) : 0u; }
            }
        }
        __builtin_amdgcn_sched_barrier(0);
        sort16_desc(cA); __builtin_amdgcn_sched_barrier(0); sort16_desc(cB); __builtin_amdgcn_sched_barrier(0); merge16_desc(cA, cB); __builtin_amdgcn_sched_barrier(0);
        xmerge16(cA, 16); __builtin_amdgcn_sched_barrier(0); xmerge16(cA, 32); __builtin_amdgcn_sched_barrier(0);
        float den = 0.f; const float mx = keyval(cA[0] & ~0xFFu);
#pragma unroll
        for (int k = 0; k < 16; ++k) den += __expf(keyval(cA[k] & ~0xFFu) - mx);
        const float inv = 1.0f / den;
#pragma unroll
        for (int kk = 0; kk < 4; ++kk) {
            const unsigned key = q == 0 ? cA[4 * kk] : (q == 1 ? cA[4 * kk + 1] : (q == 2 ? cA[4 * kk + 2] : cA[4 * kk + 3]));
            const unsigned ci = key & 0xFFu, ci1 = ci >> 4, ci2 = ci & 15u;
            unsigned i1 = 0u, i2 = 0u;
#pragma unroll
            for (int i = 0; i < 16; ++i) { i1 = (ci1 == (unsigned)i) ? (l1[i] & 0x7Fu) : i1; i2 = (ci2 == (unsigned)i) ? (l2[i] & 0x7Fu) : i2; }
            const size_t o = (size_t)t * 128 + h * 16 + 4 * kk + q;
            RE[o] = (int)(i1 * 128u + i2); RG[o] = __expf(keyval(key & ~0xFFu) - mx) * inv;
            rel[(t - (tb * UT_NT + tl_lo)) * 128 + h * 16 + 4 * kk + q] = i1 * 128u + i2;
        }
    }
    __syncthreads();
    for (int i = tid; i < ntok * 128; i += NTHR) { const int e = (int)rel[i], i1 = e >> 7, i2 = e & 127, eb = (i1 + i2) & 15;
        const unsigned pos = atomicAdd(&cnt[eb], 1u);
        if (pos < (unsigned)BCAP) loc[eb * BCAP + pos] = ((unsigned)(tl_lo * 128 + i) << 10) | (unsigned)((i1 << 3) | (i2 >> 4)); }
    __syncthreads();
    if (tid < 16) { const unsigned n = min(cnt[tid], (unsigned)BCAP); cnt[tid] = n; bbase[tid] = __hip_atomic_fetch_add(GC + tb * 16 + tid, n, __ATOMIC_RELAXED, __HIP_MEMORY_SCOPE_AGENT); }
    __syncthreads();
#pragma unroll 1
    for (int eb = 0; eb < 16; ++eb) { const unsigned n = cnt[eb], b0 = bbase[eb];
        for (unsigned i = tid; i < n; i += NTHR) if (b0 + i < (unsigned)UT_LCAP) PL[(size_t)(tb * 16 + eb) * UT_LCAP + b0 + i] = loc[eb * BCAP + i]; }
    __syncthreads();
    }
}

__device__ __forceinline__ float gelu_tanh(float x) {
    const float y = 0.7978845608028654f * (x + 0.044715f * x * x * x);
    const float th = 1.0f - 2.0f / (__expf(2.0f * y) + 1.0f);
    return 0.5f * x * (1.0f + th);
}

constexpr int UT_XB = 18432, UT_UB = UT_NE * 16, UT_STG = UT_XB + UT_UB;
static_assert(UT_XB >= UT_NT * 16 && UT_XB % 1024 == 0 && UT_UB % 1024 == 0, "LDS-DMA pieces of 1 KiB");
__device__ __forceinline__ void ut_glds(PG8_LAS unsigned char* stage, const unsigned char* xg, const unsigned char* ug, int ch, int wave, int lane) {
    const unsigned char* xn = xg + (size_t)ch * T * 16; const unsigned char* un = ug + (size_t)ch * 16384 * 16;
#pragma unroll
    for (int i = 0; i < 5; ++i) {
        const int p = i < 4 ? wave + 8 * i : (wave < 2 ? 32 + wave : wave + 24);
        const unsigned char* src = p < 18 ? xn + p * 1024 : un + (p - 18) * 1024;
        __builtin_amdgcn_global_load_lds((const unsigned*)(src + lane * 16), (PG8_LAS unsigned*)(stage + p * 1024), 16, 0, 0);
    }
}
#define UT_RAW_BARRIER() do { asm volatile("s_waitcnt lgkmcnt(0)" ::: "memory"); __builtin_amdgcn_s_barrier(); asm volatile("" ::: "memory"); } while (0)
template <int J0, int G>
__device__ __forceinline__ void ut_group(const unsigned (&po)[UT_CAP], int (&acc)[UT_CAP], const unsigned char* buf) {
    u32x4 xa[G], ua[G];
#pragma unroll
    for (int j = 0; j < G; ++j) { xa[j] = *(const u32x4*)(buf + (po[J0 + j] & 0xFFFFu)); ua[j] = *(const u32x4*)(buf + (po[J0 + j] >> 16)); }
#pragma unroll
    for (int j = 0; j < G; ++j) {
        int s = __builtin_amdgcn_sdot4((int)ua[j].x, (int)xa[j].x, acc[J0 + j], false); s = __builtin_amdgcn_sdot4((int)ua[j].y, (int)xa[j].y, s, false);
        s = __builtin_amdgcn_sdot4((int)ua[j].z, (int)xa[j].z, s, false); acc[J0 + j] = __builtin_amdgcn_sdot4((int)ua[j].w, (int)xa[j].w, s, false);
        asm volatile("" : "+v"(acc[J0 + j])); }
    asm volatile("" ::: "memory");
}
__device__ __forceinline__ void ut_compute(const unsigned (&po)[UT_CAP], int (&acc)[UT_CAP], const unsigned char* buf, int nslots) {
    static_assert(UT_CAP == 20, "slot groups: 4 x 4 unconditional, then 2 + 2 skipped (tile-uniformly) when the tile's list is short enough (slot j holds list entries 512 j ..)");
    ut_group<0, 4>(po, acc, buf); ut_group<4, 4>(po, acc, buf); ut_group<8, 4>(po, acc, buf); ut_group<12, 4>(po, acc, buf);
    if (nslots > 16) ut_group<16, 2>(po, acc, buf);
    if (nslots > 18) ut_group<18, 2>(po, acc, buf);
}
__device__ __forceinline__ void phase_utile(const Args& a, int l, float* lds, PG8_LAS unsigned char* ldsl) {
    static_assert(T == 16 * UT_NT, "16 token blocks");
    const int tid = opaque_tid();
    unsigned char* lb = (unsigned char*)lds;
    static_assert(4 * UT_STG <= MISC_OFF, "LDS map");
    const float* HS = (const float*)(a.ws + WS_HS); const float* US = (const float*)(a.ws + WS_US) + l * 16384;
    const unsigned* PL = (const unsigned*)(a.ws + WS_PL); const unsigned* GC = (const unsigned*)(a.ws + WS_CTL) + CW_GC + l * 256;
    for (int tile = blockIdx.x; tile < 256; tile += gridDim.x) {
        const int tb = tile >> 4, eb = tile & 15, tok0 = tb * UT_NT;
        const unsigned char* xg = a.ws + WS_X8 + (size_t)tok0 * 16;
        const unsigned char* ug = a.ws + WS_UB + ((size_t)(l * 64) * 16384 + (size_t)eb * UT_NE) * 16;
        const int wave = __builtin_amdgcn_readfirstlane(tid >> 6), lane = tid & 63;
        ut_glds(ldsl, xg, ug, 0, wave, lane); ut_glds(ldsl + UT_STG, xg, ug, 1, wave, lane); ut_glds(ldsl + 2 * UT_STG, xg, ug, 2, wave, lane);
        asm volatile("" ::: "memory");
        const int n = min((int)GC[tile], UT_LCAP);
        const int nslots = __builtin_amdgcn_readfirstlane((n + NTHR - 1) / NTHR);
        unsigned pr[UT_CAP], po[UT_CAP]; int acc[UT_CAP];
#pragma unroll
        for (int j = 0; j < UT_CAP; ++j) { const int idx = tid + NTHR * j; pr[j] = idx < n ? PL[(size_t)tile * UT_LCAP + idx] : 0xFFFFFFFFu; acc[j] = 0;
            po[j] = pr[j] == 0xFFFFFFFFu ? ((unsigned)UT_XB << 16) : (((pr[j] >> 17) * 16u) | ((UT_XB + (pr[j] & 1023u) * 16u) << 16)); }
        static_assert(UT_STG < 65536, "packed LDS offsets");
        static_assert(UT_NT <= 3 * NTHR && UT_NE == 2 * NTHR, "scale table registers");
        const float hs0 = HS[tok0 + tid], hs1 = HS[tok0 + tid + NTHR], hs2 = (tid + 2 * NTHR < UT_NT) ? HS[tok0 + tid + 2 * NTHR] : 0.f;
        float us0, us1;
        { const int i0 = tid, i1a = i0 >> 3; us0 = US[i1a * 128 + (((i0 & 7) << 4) | ((eb - i1a) & 15))];
          const int i2 = tid + NTHR, i1b = i2 >> 3; us1 = US[i1b * 128 + (((i2 & 7) << 4) | ((eb - i1b) & 15))]; }
        asm volatile("" ::: "memory");
#pragma unroll 1
        for (int ch = 0; ch < 61; ++ch) {
            asm volatile("s_waitcnt vmcnt(10)" ::: "memory");
            UT_RAW_BARRIER();
            ut_glds(ldsl + ((ch + 3) & 3) * UT_STG, xg, ug, ch + 3, wave, lane);
            ut_compute(po, acc, lb + (ch & 3) * UT_STG, nslots);
        }
        asm volatile("s_waitcnt vmcnt(10)" ::: "memory"); UT_RAW_BARRIER(); ut_compute(po, acc, lb + (61 & 3) * UT_STG, nslots);
        asm volatile("s_waitcnt vmcnt(5)" ::: "memory");  UT_RAW_BARRIER(); ut_compute(po, acc, lb + (62 & 3) * UT_STG, nslots);
        asm volatile("s_waitcnt vmcnt(0)" ::: "memory");  UT_RAW_BARRIER(); ut_compute(po, acc, lb + (63 & 3) * UT_STG, nslots);
        __syncthreads();
        {
            float* hsl = (float*)lb; float* usl = hsl + UT_NT;
            hsl[tid] = hs0; hsl[tid + NTHR] = hs1; if (tid + 2 * NTHR < UT_NT) hsl[tid + 2 * NTHR] = hs2;
            usl[tid] = us0; usl[tid + NTHR] = us1;
            __syncthreads();
#pragma unroll
            for (int j = 0; j < UT_CAP; ++j) if (pr[j] != 0xFFFFFFFFu) {
                const unsigned i = pr[j] >> 10;
                ((float*)(a.ws + WS_WP))[(size_t)tok0 * 128 + i] = (float)acc[j] * (hsl[i >> 7] * usl[pr[j] & 1023u]);
            }
        }
        __syncthreads();
    }
}

__device__ __forceinline__ float ub0(unsigned v) { return (float)(v & 255u); }
__device__ __forceinline__ float ub1(unsigned v) { return (float)((v >> 8) & 255u); }
__device__ __forceinline__ float ub2(unsigned v) { return (float)((v >> 16) & 255u); }
__device__ __forceinline__ float ub3(unsigned v) { return (float)(v >> 24); }
__device__ __forceinline__ void phase_experts(const Args& a, int l) {
    const int tid = opaque_tid(), lane = tid & 63, wave = tid >> 6;
    const unsigned char* VB = a.ws + WS_VB + (size_t)l * 16384 * DM;
    float* H = (float*)(a.ws + WS_H); bf16* HB = (bf16*)(a.ws + WS_HB);
    const int* RE = (const int*)(a.ws + WS_RE); const float* RG = (const float*)(a.ws + WS_RG);
    float* SSQ1 = (float*)(a.ws + WS_SSQ1);
    const float* WP = (const float*)(a.ws + WS_WP); const float* VS = (const float*)(a.ws + WS_VS) + l * 16384;
    const int tstep = gridDim.x * NWAVES, tfirst = blockIdx.x * NWAVES + wave;
    int e1a = 0, e1b = 0, e2a = 0, e2b = 0; float g1a = 0.f, g1b = 0.f, h1a = 0.f, h1b = 0.f, g2a = 0.f, g2b = 0.f, h2a = 0.f, h2b = 0.f;
    int ea = 0, eb2 = 0; float wa = 0.f, wb = 0.f;
    if (tfirst < T) { const size_t o = (size_t)tfirst * 128 + lane; ea = RE[o]; eb2 = RE[o + 64];
        wa = RG[o] * gelu_tanh(WP[o]) * VS[ea]; wb = RG[o + 64] * gelu_tanh(WP[o + 64]) * VS[eb2]; }
    if (tfirst + tstep < T) { const size_t o = (size_t)(tfirst + tstep) * 128 + lane; e1a = RE[o]; e1b = RE[o + 64]; g1a = RG[o]; g1b = RG[o + 64]; h1a = WP[o]; h1b = WP[o + 64]; }
    for (int t = tfirst; t < T; t += tstep) {
        if (t + 2 * tstep < T) { const size_t o = (size_t)(t + 2 * tstep) * 128 + lane; e2a = RE[o]; e2b = RE[o + 64]; g2a = RG[o]; g2b = RG[o + 64]; h2a = WP[o]; h2b = WP[o + 64]; }
        const float vs1a = VS[e1a], vs1b = VS[e1b];
        float out[16]; float wsum = 0.f;
        for (int rep = 0; rep < a.rep[7]; ++rep) {
#pragma unroll
        for (int i = 0; i < 16; ++i) out[i] = 0.f;
        wsum = 0.f;
#pragma unroll
        for (int hb = 0; hb < 2; ++hb) {
        const int ev = hb ? eb2 : ea; const float wv = hb ? wb : wa;
        for (int k0 = 0; k0 < 64; k0 += 16) {
            int e[16]; float wp[16];
#pragma unroll
            for (int k = 0; k < 16; ++k) { e[k] = __builtin_amdgcn_readlane(ev, k0 + k); wp[k] = __builtin_bit_cast(float, __builtin_amdgcn_readlane(__builtin_bit_cast(int, wv), k0 + k)); }
            u32x4 vr[16];
#pragma unroll
            for (int k = 0; k < 16; ++k) vr[k] = *(const u32x4*)(VB + (size_t)e[k] * DM + lane * 16);
#pragma unroll
            for (int k = 0; k < 16; ++k) { const float w = wp[k]; wsum += w;
                const unsigned v0 = vr[k].x, v1 = vr[k].y, v2 = vr[k].z, v3 = vr[k].w;
                out[0] += w * ub0(v0); out[1] += w * ub1(v0); out[2] += w * ub2(v0); out[3] += w * ub3(v0);
                out[4] += w * ub0(v1); out[5] += w * ub1(v1); out[6] += w * ub2(v1); out[7] += w * ub3(v1);
                out[8] += w * ub0(v2); out[9] += w * ub1(v2); out[10] += w * ub2(v2); out[11] += w * ub3(v2);
                out[12] += w * ub0(v3); out[13] += w * ub1(v3); out[14] += w * ub2(v3); out[15] += w * ub3(v3); }
        }
        }
        }
        const float corr = 128.0f * wsum;
        float* hp = H + (size_t)t * DM + lane * 16;
        f32x4 h0 = *(const f32x4*)hp, h1 = *(const f32x4*)(hp + 4), h2 = *(const f32x4*)(hp + 8), h3 = *(const f32x4*)(hp + 12);
        h0 += (f32x4){out[0] - corr, out[1] - corr, out[2] - corr, out[3] - corr}; h1 += (f32x4){out[4] - corr, out[5] - corr, out[6] - corr, out[7] - corr};
        h2 += (f32x4){out[8] - corr, out[9] - corr, out[10] - corr, out[11] - corr}; h3 += (f32x4){out[12] - corr, out[13] - corr, out[14] - corr, out[15] - corr};
        float ss = (h0[0] * h0[0] + h0[1] * h0[1] + h0[2] * h0[2] + h0[3] * h0[3]) + (h1[0] * h1[0] + h1[1] * h1[1] + h1[2] * h1[2] + h1[3] * h1[3])
                 + (h2[0] * h2[0] + h2[1] * h2[1] + h2[2] * h2[2] + h2[3] * h2[3]) + (h3[0] * h3[0] + h3[1] * h3[1] + h3[2] * h3[2] + h3[3] * h3[3]);
        ss = wave_sum(ss);
        if (l < NLAY - 1) {
            *(f32x4*)hp = h0; *(f32x4*)(hp + 4) = h1; *(f32x4*)(hp + 8) = h2; *(f32x4*)(hp + 12) = h3;
            *(u32x4*)(HB + (size_t)t * DM + lane * 16) = (u32x4){pk2(h0[0], h0[1]), pk2(h0[2], h0[3]), pk2(h1[0], h1[1]), pk2(h1[2], h1[3])};
            *(u32x4*)(HB + (size_t)t * DM + lane * 16 + 8) = (u32x4){pk2(h2[0], h2[1]), pk2(h2[2], h2[3]), pk2(h3[0], h3[1]), pk2(h3[2], h3[3])};
            if (lane == 0) SSQ1[t] = ss;
        } else {
            const float rs = rsqrtf(ss * (1.0f / 1024.0f) + EPS);
            float* op = nullptr;
            if (t < PT) { const int b = t / PL, ts = t % PL; if (ts >= 16) op = a.out + O_YP + ((size_t)b * 2048 + (ts - 16)) * DM; }
            else op = a.out + O_YS + (size_t)(t - PT) * DM;
            if (op) { const float* fw = a.in[I_FNW] + lane * 16; op += lane * 16;
                const f32x4 w0 = *(const f32x4*)fw, w1 = *(const f32x4*)(fw + 4), w2 = *(const f32x4*)(fw + 8), w3 = *(const f32x4*)(fw + 12);
                *(f32x4*)op = h0 * rs * w0; *(f32x4*)(op + 4) = h1 * rs * w1; *(f32x4*)(op + 8) = h2 * rs * w2; *(f32x4*)(op + 12) = h3 * rs * w3; }
        }
        ea = e1a; eb2 = e1b; wa = g1a * gelu_tanh(h1a) * vs1a; wb = g1b * gelu_tanh(h1b) * vs1b;
        e1a = e2a; e1b = e2b; g1a = g2a; g1b = g2b; h1a = h2a; h1b = h2b;
    }
}

template <int PH>
__device__ __forceinline__ void run_phase(LAS unsigned char* lds, float* ldsf) {
#if defined(__HIP_DEVICE_COMPILE__)
    typedef const __attribute__((address_space(4))) Args* KArgsPtr;
    KArgsPtr ap = (KArgsPtr)__builtin_amdgcn_kernarg_segment_ptr();
    asm volatile("" : "+s"(ap));
    const Args args = *ap;
#else
    Args args{};
#endif
    unsigned char* ws = args.ws;
    if constexpr (PH == 0) { for (int r = 0; r < args.rep[8]; ++r) phase_prologue(args, lds); }
    else {
        constexpr int l = (PH - 1) / 9, sub = (PH - 1) % 9;
        if constexpr (sub == 0 || sub == 4 || sub == 5) {
            const bf16* A = (const bf16*)(ws + (sub == 4 ? WS_MIX : WS_HB));
            const bf16* Bt = sub == 0 ? (const bf16*)(ws + WS_WIN) + (size_t)l * NIN * DM : (const bf16*)(ws + (sub == 4 ? WS_WOUT : WS_WQ)) + (size_t)l * DM * DM;
            constexpr int N = sub == 0 ? NIN : DM;
            pg8::Gemm g{A, Bt, MP, N, DM}; pg8::StaticOrder S; S.init(MP, N, gridDim.x, blockIdx.x);
            pg8::EpiUni E;
            E.mode = sub == 4 ? 1 : 0; E.O = (bf16*)(ws + (sub == 0 ? WS_PROJ : (sub == 4 ? WS_HB : WS_Q))); E.ldc = N;
            E.ssq = (const float*)(ws + (sub == 0 ? WS_SSQ1 : WS_SSQ2)); E.nparts = sub == 0 ? 1 : 16; E.H = (float*)(ws + WS_H); E.ssqp = (float*)(ws + WS_SSQ2);
            const int nrep = sub == 4 ? 1 : args.rep[sub];
            for (int r = 0; r < nrep; ++r) pg8::gemm_phase<pg8::EpiUni, pg8::StaticOrder, true, true>(lds, g, S, E);
            {
                constexpr int nwg = (MP / 256) * (N / 256);
                const int G = gridDim.x, c = blockIdx.x, rounds = (nwg + G - 1) / G, nfull = nwg - (rounds - 1) * G;
                const int wave = opaque_tid() >> 6;
                int gw, NGW;
                if (nfull < G) { gw = (c - nfull) * NWAVES + wave; NGW = (G - nfull) * NWAVES; if (c < nfull) gw = -1; }
                else { gw = c * NWAVES + wave; NGW = G * NWAVES; }
                if (gw >= 0) {
                    if constexpr (sub == 0) quant_u_layer(args, l, gw, NGW);
                    else if constexpr (sub == 4) quant_v_layer(args, l, 0, 8192, gw, NGW);
                    else { quant_v_layer(args, l, 8192, 16384, gw, NGW); xquant_tokens(args, gw, NGW); }
                }
            }
            if (args.ph_hi - args.ph_lo > 1) { if constexpr (sub == 0) r1_stage(args, l, ldsf); else if constexpr (sub == 5) route_stage(args, l, ldsf); }
        } else if constexpr (sub == 1) { for (int r = 0; r < args.rep[1]; ++r) phase_r1(args, l, ldsf, r); }
        else if constexpr (sub == 2) { phase_r2(args, l); if (args.ph_hi - args.ph_lo > 1) r3_stage(args, l, ldsf); }
        else if constexpr (sub == 3) { for (int r = 0; r < args.rep[3]; ++r) phase_r3(args, l, ldsf, r); }
        else if constexpr (sub == 6) { for (int r = 0; r < args.rep[6]; ++r) phase_route(args, l, ldsf); }
        else if constexpr (sub == 7) { for (int r = 0; r < args.rep[9]; ++r) phase_utile(args, l, ldsf, lds); }
        else phase_experts(args, l);
    }
}

constexpr int NPHASE = 1 + 9 * NLAY;
__global__ void __launch_bounds__(NTHR, 2) fwd_kernel(Args kargs) {
    extern __shared__ __attribute__((aligned(16))) unsigned char lds_raw[];
    LAS unsigned char* lds = (LAS unsigned char*)lds_raw;
    float* ldsf = (float*)lds_raw;
    volatile LAS unsigned* MISC = (volatile LAS unsigned*)(lds + MISC_OFF);
    if (kargs.ph_hi - kargs.ph_lo > 1) {
        if (threadIdx.x < 32) MISC[threadIdx.x] = 0u;
        __syncthreads();
        const XcdBarrier b0 = xcd_barrier_post((unsigned*)(kargs.ws + WS_CTL) + CW_BAR, MISC + 8);
        if (threadIdx.x == 0) MISC[10] = b0.x;
        __syncthreads();
    }
    const int lo = kargs.ph_lo, hi = kargs.ph_hi;
#define RUN_PHASE(PH) if (lo <= (PH) && (PH) < hi) { run_phase<(PH)>(lds, ldsf); if ((PH) + 1 < hi) { for (int xb = 0; xb < kargs.rep[4]; ++xb) { XcdBarrier bar; bar.bar = (unsigned*)(kargs.ws + WS_CTL) + CW_BAR; bar.x = MISC[10]; bar.st = MISC + 8; xcd_barrier(bar); } } }
    RUN_PHASE(0)
    RUN_PHASE(1) RUN_PHASE(2) RUN_PHASE(3) RUN_PHASE(4) RUN_PHASE(5) RUN_PHASE(6) RUN_PHASE(7) RUN_PHASE(8)
    RUN_PHASE(9) RUN_PHASE(10) RUN_PHASE(11) RUN_PHASE(12) RUN_PHASE(13) RUN_PHASE(14) RUN_PHASE(15) RUN_PHASE(16)
    RUN_PHASE(17) RUN_PHASE(18) RUN_PHASE(19) RUN_PHASE(20) RUN_PHASE(21) RUN_PHASE(22) RUN_PHASE(23) RUN_PHASE(24)
    RUN_PHASE(25) RUN_PHASE(26) RUN_PHASE(27) RUN_PHASE(28) RUN_PHASE(29) RUN_PHASE(30) RUN_PHASE(31) RUN_PHASE(32)
    RUN_PHASE(33) RUN_PHASE(34) RUN_PHASE(35) RUN_PHASE(36) RUN_PHASE(37) RUN_PHASE(38) RUN_PHASE(39) RUN_PHASE(40)
#undef RUN_PHASE
}

extern "C" void kernel_launch(void* const* d_in, const int* in_sizes, int n_in, void* d_out, int out_size, void* d_ws, size_t ws_size, hipStream_t stream) {
    static int grid = 0;
    if (grid == 0) {
        if (n_in != 25 || ws_size < WS_END || out_size != 72974336) { fprintf(stderr, "kernel_launch: unexpected shapes (n_in %d, out %d, ws %zu, need %zu)\n", n_in, out_size, ws_size, (size_t)WS_END); grid = -1; return; }
        int dev = 0, cus = 0, per_cu = 0;
        if (hipGetDevice(&dev) != hipSuccess || hipDeviceGetAttribute(&cus, hipDeviceAttributeMultiprocessorCount, dev) != hipSuccess) { grid = -1; return; }
        if (hipFuncSetAttribute((const void*)fwd_kernel, hipFuncAttributeMaxDynamicSharedMemorySize, LDS_BYTES) != hipSuccess) { fprintf(stderr, "kernel_launch: hipFuncSetAttribute failed\n"); grid = -1; return; }
        if (hipOccupancyMaxActiveBlocksPerMultiprocessor(&per_cu, (const void*)fwd_kernel, NTHR, LDS_BYTES) != hipSuccess || per_cu < 1) { fprintf(stderr, "kernel_launch: occupancy query says %d\n", per_cu); per_cu = 1; }
        (void)hipGetLastError();
        grid = cus;
    }
    if (grid < 0) return;
    (void)hipMemsetAsync((char*)d_ws + WS_CTL, 0, CTL_BYTES, stream);
    Args a{};
    for (int i = 0; i < 25; ++i) a.in[i] = (const float*)d_in[i];
    a.out = (float*)d_out; a.ws = (unsigned char*)d_ws;
    { const int rp[10] = PROBE_REP; for (int i = 0; i < 10; ++i) a.rep[i] = rp[i]; }
#if MK_ONE_LAUNCH
    a.ph_lo = 0; a.ph_hi = NPHASE;
    void* kargs[] = {&a};
    hipError_t e = hipLaunchCooperativeKernel((const void*)fwd_kernel, dim3(grid), dim3(NTHR), kargs, LDS_BYTES, stream);
    if (e != hipSuccess) fprintf(stderr, "cooperative launch failed: %s (grid %d)\n", hipGetErrorString(e), grid);
#else
    for (int ph = 0; ph < NPHASE; ++ph) {
        a.ph_lo = ph; a.ph_hi = ph + 1;
        hipLaunchKernelGGL(fwd_kernel, dim3(grid), dim3(NTHR), LDS_BYTES, stream, a);
    }
#endif
}
```
